# Optimizing an MI355X kernel written in HIP

```python
import jax
import jax.numpy as jnp
from jax import lax
import numpy as np

D_MODEL = 2048
BATCH = 2
SEQ = 8192
DEPTH = 4

GRID_W = 64
CTX_LEN = 256
EPS = 1e-6
LOG_FLOOR = 1e-30
N_EVEN = (DEPTH + 1) // 2
N_ODD = DEPTH // 2
N_MOD = 6

A_HEADS = 8
A_DK = 128
A_DV = D_MODEL // 16
A_KWIDTH = A_HEADS * A_DK
A_WIDTH = A_HEADS * A_DV
SCAN_CHUNK = 64

B_GROUPS = 8
B_CH = D_MODEL // 16
B_WIDTH = B_GROUPS * B_CH
B_CHUNK = 128

Q_OFF = 0
FF_OFF = Q_OFF + A_KWIDTH
FB_OFF = FF_OFF + A_KWIDTH
I_OFF = FB_OFF + A_KWIDTH
G_OFF = I_OFF + A_WIDTH
U_OFF = G_OFF + A_WIDTH
V_OFF = U_OFF + B_WIDTH
IN_COLS = V_OFF + B_WIDTH
MIX_WIDTH = A_WIDTH + B_WIDTH

C_GROUPS = 4
C_CH = D_MODEL // C_GROUPS
POOL_WINDOWS = (2, 4, 8, 16)

D_FF = 4 * D_MODEL

kernel_name = 'hybrid_hgrn2_chunkmlp_pool_dit'


def rms_norm(x, g):
    xf = x.astype(jnp.float32)
    y = xf * lax.rsqrt(jnp.mean(xf * xf, axis=-1, keepdims=True) + EPS)
    return (y * g.astype(jnp.float32)).astype(x.dtype)


def modulate(h, shift, scale):
    return h * (1.0 + scale[:, None, :]) + shift[:, None, :]


def ada_mods(cvec, w, b):
    m = jax.nn.silu(cvec) @ w + b
    return jnp.split(m, N_MOD, axis=-1)


def split_heads(t, dh):
    return t.reshape(t.shape[:-1] + (t.shape[-1] // dh, dh))


def flip_seq(t):
    return jnp.flip(t, axis=1)


def lower_bounds(lb_logits):
    p = jax.nn.softmax(lb_logits.astype(jnp.float32), axis=1)
    return jnp.cumsum(p, axis=1) - p[:, :1]


def hgrn_gates(f_pre, lb):
    f = f_pre.astype(jnp.float32)
    fg = lb + (1.0 - lb) * jax.nn.sigmoid(f)
    log_f = jnp.log(jnp.maximum(fg, LOG_FLOOR))
    k = (1.0 - lb) * jax.nn.sigmoid(-f)
    return split_heads(k, A_DK), split_heads(log_f, A_DK)


def gla_chunk_scan(q, k, v, log_f, s0):
    bsz, seq_len, n_heads, _ = q.shape
    dv = v.shape[-1]
    n_chunks = seq_len // SCAN_CHUNK

    def to_chunks(t):
        return t.reshape(bsz, n_chunks, SCAN_CHUNK, n_heads, t.shape[-1]).transpose(1, 0, 3, 2, 4)

    lower = jnp.tril(jnp.ones((SCAN_CHUNK, SCAN_CHUNK), dtype=bool))[None, None, :, :, None]

    def step(state, blk):
        qb, kb, vb, gb = blk
        b = jnp.cumsum(gb, axis=2)
        o_inter = jnp.einsum('bhtk,bhkv->bhtv', qb * jnp.exp(b), state)
        diff = b[:, :, :, None, :] - b[:, :, None, :, :]
        decay = jnp.where(lower, jnp.exp(jnp.minimum(diff, 0.0)), 0.0)
        scores = jnp.einsum('bhtk,bhsk,bhtsk->bhts', qb, kb, decay)
        o_intra = jnp.einsum('bhts,bhsv->bhtv', scores, vb)
        b_last = b[:, :, -1:, :]
        new_state = (jnp.exp(b_last[:, :, 0, :])[..., None] * state
                     + jnp.einsum('bhsk,bhsv->bhkv', kb * jnp.exp(b_last - b), vb))
        return new_state, o_inter + o_intra

    s_fin, o = lax.scan(step, s0, (to_chunks(q), to_chunks(k), to_chunks(v), to_chunks(log_f)))
    o = o.transpose(1, 0, 3, 2, 4).reshape(bsz, seq_len, n_heads, dv)
    return o, s_fin


def gla_final_state(k, v, log_f):
    b = jnp.cumsum(log_f, axis=1)
    w = jnp.exp(b[:, -1:] - b)
    return jnp.einsum('blhk,blhv->bhkv', k * w, v)


def hgrn_stream(q, f_fwd, f_bwd, i, lb_f, lb_b, s0_f, s0_b):
    kf, gf = hgrn_gates(f_fwd, lb_f)
    kb, gb = hgrn_gates(f_bwd, lb_b)
    qh = split_heads(q.astype(jnp.float32), A_DK)
    vh = split_heads(i.astype(jnp.float32), A_DV)
    o_f, s_f = gla_chunk_scan(qh, kf, vh, gf, s0_f)
    o_b, s_b = gla_chunk_scan(flip_seq(qh), flip_seq(kb), flip_seq(vh), flip_seq(gb), s0_b)
    return o_f + flip_seq(o_b), s_f, s_b


def hgrn_final_states(f_fwd, f_bwd, i, lb_f, lb_b):
    kf, gf = hgrn_gates(f_fwd, lb_f)
    kb, gb = hgrn_gates(f_bwd, lb_b)
    vh = split_heads(i.astype(jnp.float32), A_DV)
    s_f = gla_final_state(kf, vh, gf)
    s_b = gla_final_state(flip_seq(kb), flip_seq(vh), flip_seq(gb))
    return s_f, s_b


def hgrn_readout(o, g, norm_g):
    o = o * lax.rsqrt(jnp.mean(o * o, axis=-1, keepdims=True) + EPS)
    o = o.reshape(o.shape[:2] + (A_WIDTH,)) * norm_g.astype(jnp.float32)
    return (o * jax.nn.silu(g.astype(jnp.float32))).astype(g.dtype)


def chunk_token_mlp(u, v, ws, bias, vnorm_g):
    bsz, seq_len, _ = u.shape
    u32 = jax.nn.gelu(u.astype(jnp.float32), approximate=False)
    vg = split_heads(jax.nn.gelu(v.astype(jnp.float32), approximate=False), B_CH)
    mu = jnp.mean(vg, axis=-1, keepdims=True)
    var = jnp.mean(jnp.square(vg - mu), axis=-1, keepdims=True)
    vn = (vg - mu) * lax.rsqrt(var + EPS) * split_heads(vnorm_g.astype(jnp.float32), B_CH)
    vc = vn.reshape(bsz, seq_len // B_CHUNK, B_CHUNK, B_GROUPS, B_CH)
    mixed = (jnp.einsum('gts,bnsgc->bntgc', ws.astype(jnp.float32), vc)
             + bias.astype(jnp.float32).T[:, :, None])
    return (u32 * mixed.reshape(bsz, seq_len, B_WIDTH)).astype(v.dtype)


def even_mixer(h_lat, h_ctx, w_in, w_out, lb_f, lb_b, a_norm_g, b_ws, b_bias, b_vnorm_g, ctx_out_needed):
    bsz = h_ctx.shape[0]
    if ctx_out_needed:
        zero = jnp.zeros((bsz, A_HEADS, A_DK, A_DV), jnp.float32)
        pc = h_ctx @ w_in
        oc, s_f, s_b = hgrn_stream(pc[..., Q_OFF:FF_OFF], pc[..., FF_OFF:FB_OFF], pc[..., FB_OFF:I_OFF],
                                   pc[..., I_OFF:G_OFF], lb_f, lb_b, zero, zero)
        yc = jnp.concatenate([hgrn_readout(oc, pc[..., G_OFF:U_OFF], a_norm_g),
                              chunk_token_mlp(pc[..., U_OFF:V_OFF], pc[..., V_OFF:IN_COLS], b_ws, b_bias, b_vnorm_g)],
                             axis=-1) @ w_out
    else:
        pc = h_ctx @ w_in[:, FF_OFF:G_OFF]
        s_f, s_b = hgrn_final_states(pc[..., :A_KWIDTH], pc[..., A_KWIDTH:2 * A_KWIDTH],
                                     pc[..., 2 * A_KWIDTH:], lb_f, lb_b)
        yc = None
    pl = h_lat @ w_in
    ol, _, _ = hgrn_stream(pl[..., Q_OFF:FF_OFF], pl[..., FF_OFF:FB_OFF], pl[..., FB_OFF:I_OFF],
                           pl[..., I_OFF:G_OFF], lb_f, lb_b, s_f, s_b)
    yl = jnp.concatenate([hgrn_readout(ol, pl[..., G_OFF:U_OFF], a_norm_g),
                          chunk_token_mlp(pl[..., U_OFF:V_OFF], pl[..., V_OFF:IN_COLS], b_ws, b_bias, b_vnorm_g)],
                         axis=-1) @ w_out
    return yl, yc


def window_bounds(n, k):
    t = np.arange(n)
    return np.clip(t - k // 2, 0, n), np.clip(t - k // 2 + k, 0, n)


def pool_minus_self_2d(x, k):
    bsz, seq_len, ch = x.shape
    rows = seq_len // GRID_W
    g = x.reshape(bsz, rows, GRID_W, ch)
    sat = jnp.pad(jnp.cumsum(jnp.cumsum(g, axis=1), axis=2), ((0, 0), (1, 0), (1, 0), (0, 0)))
    rlo, rhi = window_bounds(rows, k)
    clo, chi = window_bounds(GRID_W, k)

    def corner(r, cidx):
        return sat[:, r][:, :, cidx]

    s = corner(rhi, chi) - corner(rlo, chi) - corner(rhi, clo) + corner(rlo, clo)
    cnt = ((rhi - rlo)[:, None] * (chi - clo)[None, :]).astype(np.float32)
    return (s / cnt[None, :, :, None] - g).reshape(bsz, seq_len, ch)


def pool_minus_self_1d(x, k):
    seq_len = x.shape[1]
    cs = jnp.pad(jnp.cumsum(x, axis=1), ((0, 0), (1, 0), (0, 0)))
    lo, hi = window_bounds(seq_len, k)
    return (cs[:, hi] - cs[:, lo]) / (hi - lo).astype(np.float32)[None, :, None] - x


def pool_mixer(h, w_in, w_grp, b_grp, scale, on_grid):
    p = (h @ w_in).astype(jnp.float32)
    pool = pool_minus_self_2d if on_grid else pool_minus_self_1d
    z = jnp.stack([pool(p[..., gi * C_CH:(gi + 1) * C_CH], k) for gi, k in enumerate(POOL_WINDOWS)], axis=2)
    y = jnp.einsum('blgc,gcd->blgd', z, w_grp.astype(jnp.float32)) + b_grp.astype(jnp.float32)
    return (y.reshape(h.shape[:2] + (D_MODEL,)) * scale.astype(jnp.float32)).astype(h.dtype)


def sq_relu_mlp(h, w1, w2):
    return jnp.square(jax.nn.relu(h @ w1)) @ w2


def setup_inputs(seed: int = 0) -> dict:
    key = jax.random.key(seed)
    ks = jax.random.split(key, 22)

    def nrm(k, shape, s):
        return jax.random.normal(k, shape, jnp.float32) * s

    d = D_MODEL
    return {
        'x': nrm(ks[0], (BATCH, SEQ, d), 1.0),
        'c': nrm(ks[1], (BATCH, d), 1.0),
        'ctx': nrm(ks[2], (BATCH, CTX_LEN, d), 1.0),
        'c_ctx': nrm(ks[3], (d,), 1.0),
        'w_ada': nrm(ks[4], (DEPTH, d, N_MOD * d), 0.5 * d ** -0.5),
        'b_ada': nrm(ks[5], (DEPTH, N_MOD * d), 0.01),
        'g_norm_mix': 1.0 + nrm(ks[6], (DEPTH, d), 0.05),
        'g_norm_ffn': 1.0 + nrm(ks[7], (DEPTH, d), 0.05),
        'w_in_even': nrm(ks[8], (N_EVEN, d, IN_COLS), d ** -0.5),
        'w_out_even': nrm(ks[9], (N_EVEN, MIX_WIDTH, d), MIX_WIDTH ** -0.5),
        'lb_logits': nrm(ks[10], (2, N_EVEN, A_KWIDTH), 0.5),
        'g_hgrn_out': 1.0 + nrm(ks[11], (N_EVEN, A_WIDTH), 0.05),
        'w_spatial': nrm(ks[12], (N_EVEN, B_GROUPS, B_CHUNK, B_CHUNK), B_CHUNK ** -0.5),
        'b_spatial': 1.0 + nrm(ks[13], (N_EVEN, B_GROUPS, B_CHUNK), 0.02),
        'g_spatial_v': 1.0 + nrm(ks[14], (N_EVEN, B_WIDTH), 0.05),
        'w_in_pool': nrm(ks[15], (N_ODD, d, d), d ** -0.5),
        'w_grp_pool': nrm(ks[16], (N_ODD, C_GROUPS, C_CH, C_CH), C_CH ** -0.5),
        'b_grp_pool': nrm(ks[17], (N_ODD, C_GROUPS, C_CH), 0.01),
        'scale_pool': 1.0 + nrm(ks[18], (N_ODD, d), 0.05),
        'w_ffn_up': nrm(ks[19], (DEPTH, d, D_FF), d ** -0.5),
        'w_ffn_down': nrm(ks[20], (DEPTH, D_FF, d), D_FF ** -0.5),
        'g_norm_final': 1.0 + nrm(ks[21], (d,), 0.05),
    }


def reference(x, c, ctx, c_ctx, w_ada, b_ada, g_norm_mix, g_norm_ffn, w_in_even, w_out_even, lb_logits,
              g_hgrn_out, w_spatial, b_spatial, g_spatial_v, w_in_pool, w_grp_pool, b_grp_pool, scale_pool,
              w_ffn_up, w_ffn_down, g_norm_final):
    lbs = lower_bounds(lb_logits)
    last_even = DEPTH - 1 if (DEPTH - 1) % 2 == 0 else DEPTH - 2
    c_ctx_row = c_ctx[None, :]
    ctx_s = ctx
    for layer in range(DEPTH):
        ctx_out_needed = layer < last_even
        ctx_read = layer <= last_even
        sh1, sc1, gt1, sh2, sc2, gt2 = ada_mods(c, w_ada[layer], b_ada[layer])
        hl = modulate(rms_norm(x, g_norm_mix[layer]), sh1, sc1)
        hc = None
        if ctx_read:
            csh1, csc1, cgt1, csh2, csc2, cgt2 = ada_mods(c_ctx_row, w_ada[layer], b_ada[layer])
            hc = modulate(rms_norm(ctx_s, g_norm_mix[layer]), csh1, csc1)
        if layer % 2 == 0:
            e = layer // 2
            yl, yc = even_mixer(hl, hc, w_in_even[e], w_out_even[e], lbs[0, e], lbs[1, e], g_hgrn_out[e],
                                w_spatial[e], b_spatial[e], g_spatial_v[e], ctx_out_needed)
        else:
            o = layer // 2
            yl = pool_mixer(hl, w_in_pool[o], w_grp_pool[o], b_grp_pool[o], scale_pool[o], True)
            yc = pool_mixer(hc, w_in_pool[o], w_grp_pool[o], b_grp_pool[o], scale_pool[o], False) if ctx_out_needed else None
        x = x + gt1[:, None, :] * yl
        x = x + gt2[:, None, :] * sq_relu_mlp(modulate(rms_norm(x, g_norm_ffn[layer]), sh2, sc2),
                                              w_ffn_up[layer], w_ffn_down[layer])
        if ctx_out_needed:
            ctx_s = ctx_s + cgt1[:, None, :] * yc
            ctx_s = ctx_s + cgt2[:, None, :] * sq_relu_mlp(modulate(rms_norm(ctx_s, g_norm_ffn[layer]), csh2, csc2),
                                                          w_ffn_up[layer], w_ffn_down[layer])
    return rms_norm(x, g_norm_final)
```

```cpp
#include <hip/hip_runtime.h>
#include <cstdio>
#include <cstdint>

#ifndef MK_PER_PHASE
#define MK_PER_PHASE 0
#endif

namespace pg8 {
#define PG8_LAS __attribute__((address_space(3)))
#define GAS __attribute__((address_space(1)))
typedef unsigned short bf16_t;
typedef short bf16x8 __attribute__((ext_vector_type(8)));
typedef float f32x4 __attribute__((ext_vector_type(4)));
typedef float f32x2 __attribute__((ext_vector_type(2)));
typedef unsigned u32x4 __attribute__((ext_vector_type(4)));
typedef unsigned u32x2 __attribute__((ext_vector_type(2)));
constexpr int BM = 256, BK = 64, HALF = 128, HTB = HALF * BK * 2, STAGE_BYTES = 8 * HTB, NXCD = 8, WGM = 8;

__host__ __device__ __forceinline__ int lds_byte(int r, int c) { const int st = (r >> 4) * 2 + (c >> 5), rr = r & 15, cc = c & 31, ob = rr * 64 + cc * 2; return st * 1024 + (ob ^ (((ob >> 9) & 1) << 5)); }
__host__ __device__ __forceinline__ void stage_rc(int b, int& R, int& C) { const int st = b / 1024, sb = b % 1024, swz = sb ^ (((sb >> 9) & 1) << 5); R = (st >> 1) * 16 + swz / 64; C = (st & 1) * 32 + (swz % 64) / 2; }
__host__ __device__ __forceinline__ int perm32(int rho) { const int n = rho >> 4, i = rho & 15; return 8 * (i >> 2) + 4 * n + (i & 3); }

struct Unit { int pm, pn; };
struct Gemm { const GAS bf16_t* A; const GAS bf16_t* Bt; int lda, ldb, K, agrp; };

struct StaticOrder {
    int nM, nN, nwg, G, c;
    __host__ __device__ void init(int nM_, int nN_, int G_, int c_) { nM = nM_; nN = nN_; nwg = nM * nN; G = G_; c = c_; }
    __host__ __device__ bool next(int i, Unit& u) const {
        const long L = (long)i * G + c; if (L >= nwg) return false;
        int wgid = (int)L; { const int q = nwg / NXCD, r = nwg % NXCD, xcd = wgid % NXCD, off = wgid / NXCD; wgid = (xcd < r ? xcd * (q + 1) : r * (q + 1) + (xcd - r) * q) + off; }
        const int nig = WGM * nN, gid = wgid / nig, fm = gid * WGM, gsz = (nM - fm) < WGM ? (nM - fm) : WGM;
        u.pm = fm + ((wgid % nig) % gsz); u.pn = (wgid % nig) / gsz; return true;
    }
};

__device__ __forceinline__ unsigned cvt_pk_bf16(float lo, float hi) { unsigned r; asm volatile("v_cvt_pk_bf16_f32 %0, %1, %2" : "=v"(r) : "v"(lo), "v"(hi)); return r; }
__device__ __forceinline__ f32x2 gelu_pk(f32x2 v) {
    const f32x2 av = __builtin_elementwise_abs(v), d = av * 0.2316418882f + 1.0f;
    f32x2 t; t.x = __builtin_amdgcn_rcpf(d.x); t.y = __builtin_amdgcn_rcpf(d.y);
    f32x2 q = t * 0.5307027145f + (-0.7265760135f); q = q * t + 0.7107068705f; q = q * t + (-0.142248368f); q = q * t + 0.127414796f; q = q * t;
    const f32x2 s = (v * v) * (-0.72134752044f);
    f32x2 e; e.x = __builtin_amdgcn_exp2f(s.x); e.y = __builtin_amdgcn_exp2f(s.y);
    const f32x2 m = v * (q * e), r = v - m;
    f32x2 o; o.x = v.x < 0.f ? m.x : r.x; o.y = v.y < 0.f ? m.y : r.y; return o;
}
__device__ __forceinline__ f32x4 gelu4(f32x4 v) { const f32x2 a = gelu_pk((f32x2){v[0], v[1]}), b = gelu_pk((f32x2){v[2], v[3]}); return (f32x4){a.x, a.y, b.x, b.y}; }
__device__ __forceinline__ float sigmoidf_(float x) { return __builtin_amdgcn_rcpf(1.0f + __expf(-x)); }

__device__ __forceinline__ size_t hm_off(int r, int h) { return r < 16384 ? ((size_t)(((r >> 13) * 8 + h) * 8192 + (r & 8191))) * 128 : (size_t)16 * 8192 * 128 + ((size_t)((((r - 16384) >> 8) * 8 + h) * 256 + ((r - 16384) & 255))) * 128; }
constexpr size_t HM_ELEMS = (size_t)16 * (8192 + 256) * 128;
struct EpiIn {
    static constexpr bool PERM = true;
    GAS bf16_t* P; GAS float* Gl; const GAS float* lb;
    GAS bf16_t* QH; GAS bf16_t* KH; GAS bf16_t* VH;
    const GAS unsigned long long* rs; const GAS float* cb;
    __device__ __forceinline__ void operator()(const f32x4 (&acc)[2][2][4][2], const Unit& u, int wr, int wc, int fr, int fq) const {
        const int seg = u.pn >> 2;
        const int row0 = u.pm * BM + wr * 64 + fr, col0 = u.pn * BM + wc * 32 + 8 * fq;
        const GAS float* cbr = cb + (size_t)(u.pm < 32 ? 0 : 1) * 16384;
        if (seg == 1 || seg == 2) {
#pragma unroll
            for (int bj = 0; bj < 2; ++bj) {
                const int c = col0 + bj * HALF;
                const f32x4 l0 = *(const GAS f32x4*)(lb + c - 1024), l1 = *(const GAS f32x4*)(lb + c - 1024 + 4);
                const f32x4 c0 = *(const GAS f32x4*)(cbr + c), c1 = *(const GAS f32x4*)(cbr + c + 4);
#pragma unroll
                for (int ai = 0; ai < 2; ++ai)
#pragma unroll
                    for (int m = 0; m < 4; ++m) {
                        const size_t row = (size_t)(row0 + ai * HALF + m * 16);
                        const float rstd = rsqrtf((float)rs[row] * (1.0f / (2048.0f * 1048576.0f)) + 1e-6f);
                        f32x4 g0, g1;
#pragma unroll
                        for (int j = 0; j < 4; ++j) {
                            { const float f = fminf(fmaxf(acc[ai][bj][m][0][j] * rstd + c0[j], -60.f), 60.f), e = __expf(-f), sg = __builtin_amdgcn_rcpf(1.0f + e), l = l0[j];
                              g0[j] = __logf(fmaxf(l + (1.0f - l) * sg, 1e-30f)); }
                            { const float f = fminf(fmaxf(acc[ai][bj][m][1][j] * rstd + c1[j], -60.f), 60.f), e = __expf(-f), sg = __builtin_amdgcn_rcpf(1.0f + e), l = l1[j];
                              g1[j] = __logf(fmaxf(l + (1.0f - l) * sg, 1e-30f)); }
                        }
                        const size_t ho = (size_t)(seg - 1) * HM_ELEMS + hm_off((int)row, (c >> 7) & 7) + (c & 127);
                        *(GAS f32x4*)(Gl + ho) = g0; *(GAS f32x4*)(Gl + ho + 4) = g1;
                    }
            }
        } else {
            const int mode = (seg == 4) ? 1 : (seg >= 5 ? 2 : 0);
#pragma unroll
            for (int ai = 0; ai < 2; ++ai)
#pragma unroll
                for (int m = 0; m < 4; ++m) {
                    const size_t row = (size_t)(row0 + ai * HALF + m * 16);
                    const float rstd = rsqrtf((float)rs[row] * (1.0f / (2048.0f * 1048576.0f)) + 1e-6f);
#pragma unroll
                    for (int bj = 0; bj < 2; ++bj) {
                        f32x4 v0 = acc[ai][bj][m][0] * rstd + *(const GAS f32x4*)(cbr + col0 + bj * HALF), v1 = acc[ai][bj][m][1] * rstd + *(const GAS f32x4*)(cbr + col0 + bj * HALF + 4);
                        if (mode == 1) {
#pragma unroll
                            for (int j = 0; j < 4; ++j) { v0[j] = v0[j] * sigmoidf_(v0[j]); v1[j] = v1[j] * sigmoidf_(v1[j]); }
                        } else if (mode == 2) { v0 = gelu4(v0); v1 = gelu4(v1); }
                        u32x4 w; w.x = cvt_pk_bf16(v0[0], v0[1]); w.y = cvt_pk_bf16(v0[2], v0[3]); w.z = cvt_pk_bf16(v1[0], v1[1]); w.w = cvt_pk_bf16(v1[2], v1[3]);
                        const int c = col0 + bj * HALF;
                        if (seg == 0 || seg == 3) *(GAS u32x4*)((seg == 0 ? QH : VH) + hm_off((int)row, (c >> 7) & 7) + (c & 127)) = w;
                        else *(GAS u32x4*)(P + row * 7168 + c) = w;
                    }
                }
        }
    }
};
template <int ACT> struct EpiAct {
    static constexpr bool PERM = true;
    GAS bf16_t* O; int ldc; const GAS unsigned long long* rs; const GAS float* cb;
    __device__ __forceinline__ void operator()(const f32x4 (&acc)[2][2][4][2], const Unit& u, int wr, int wc, int fr, int fq) const {
        const int row0 = u.pm * BM + wr * 64 + fr, col0 = u.pn * BM + wc * 32 + 8 * fq;
        const GAS float* cbr = cb + (size_t)(u.pm < 32 ? 0 : 1) * 16384 + col0;
        const f32x4 cb00 = *(const GAS f32x4*)(cbr), cb01 = *(const GAS f32x4*)(cbr + 4), cb10 = *(const GAS f32x4*)(cbr + HALF), cb11 = *(const GAS f32x4*)(cbr + HALF + 4);
#pragma unroll
        for (int ai = 0; ai < 2; ++ai)
#pragma unroll
            for (int m = 0; m < 4; ++m) {
                GAS bf16_t* rowp = O + (size_t)(row0 + ai * HALF + m * 16) * ldc + col0;
                const float rstd = rsqrtf((float)rs[row0 + ai * HALF + m * 16] * (1.0f / (2048.0f * 1048576.0f)) + 1e-6f);
#pragma unroll
                for (int bj = 0; bj < 2; ++bj) {
                    f32x4 v0 = acc[ai][bj][m][0] * rstd + (bj ? cb10 : cb00), v1 = acc[ai][bj][m][1] * rstd + (bj ? cb11 : cb01);
                    if (ACT == 1) {
#pragma unroll
                        for (int j = 0; j < 4; ++j) { const float a = fmaxf(v0[j], 0.f), b = fmaxf(v1[j], 0.f); v0[j] = a * a; v1[j] = b * b; }
                    }
                    u32x4 w; w.x = cvt_pk_bf16(v0[0], v0[1]); w.y = cvt_pk_bf16(v0[2], v0[3]); w.z = cvt_pk_bf16(v1[0], v1[1]); w.w = cvt_pk_bf16(v1[2], v1[3]);
                    *(GAS u32x4*)(rowp + bj * HALF) = w;
                }
            }
    }
};
__device__ __forceinline__ f32x4 bf4lo(u32x4 w) { return (f32x4){__builtin_bit_cast(float, w.x << 16), __builtin_bit_cast(float, w.x & 0xffff0000u), __builtin_bit_cast(float, w.y << 16), __builtin_bit_cast(float, w.y & 0xffff0000u)}; }
__device__ __forceinline__ f32x4 bf4hi(u32x4 w) { return (f32x4){__builtin_bit_cast(float, w.z << 16), __builtin_bit_cast(float, w.z & 0xffff0000u), __builtin_bit_cast(float, w.w << 16), __builtin_bit_cast(float, w.w & 0xffff0000u)}; }
struct EpiRes {
    static constexpr bool PERM = true;
    GAS bf16_t* X; const GAS float* Xin; bool xf32;
    const GAS float* gate; int gstride; const GAS float* bias; const GAS float* scale;
    GAS bf16_t* Hn; const GAS float* gsn; GAS unsigned long long* rsn;
    GAS float* Xout32;
    __device__ __forceinline__ void operator()(const f32x4 (&acc)[2][2][4][2], const Unit& u, int wr, int wc, int fr, int fq) const {
        const int mr = u.pm < 32 ? 0 : (u.pm < 64 ? 1 : 2);
        const GAS float* gt = gate + (size_t)mr * gstride;
        const int row0 = u.pm * BM + wr * 64 + fr, col0 = u.pn * BM + wc * 32 + 8 * fq;
        f32x4 ga[2][2], gs[2][2];
#pragma unroll
        for (int bj = 0; bj < 2; ++bj)
#pragma unroll
            for (int n = 0; n < 2; ++n) {
                const int c = col0 + bj * HALF + 4 * n;
                gs[bj][n] = Hn ? *(const GAS f32x4*)(gsn + (size_t)mr * 2048 + c) : (f32x4){0.f, 0.f, 0.f, 0.f};
                ga[bj][n] = *(const GAS f32x4*)(gt + c);
                if (scale) ga[bj][n] = ga[bj][n] * *(const GAS f32x4*)(scale + c);
            }
#pragma unroll
        for (int ai = 0; ai < 2; ++ai)
#pragma unroll
        for (int mp = 0; mp < 4; mp += 2) {
            u32x4 raw[2][2][2];
#pragma unroll
            for (int m2 = 0; m2 < 2; ++m2)
#pragma unroll
                for (int bj = 0; bj < 2; ++bj) {
                    const size_t o = (size_t)(row0 + ai * HALF + (mp + m2) * 16) * 2048 + col0 + bj * HALF;
                    if (xf32) { raw[m2][bj][0] = *(const GAS u32x4*)(Xin + o); raw[m2][bj][1] = *(const GAS u32x4*)(Xin + o + 4); }
                    else { raw[m2][bj][0] = *(const GAS u32x4*)(X + o); raw[m2][bj][1] = raw[m2][bj][0]; }
                }
            asm volatile("" ::: "memory");
#pragma unroll
            for (int m2 = 0; m2 < 2; ++m2) {
                const int m = mp + m2;
                const size_t row = (size_t)(row0 + ai * HALF + m * 16);
                float ss = 0.f;
#pragma unroll
                for (int bj = 0; bj < 2; ++bj) {
                    const f32x4 xi0 = xf32 ? __builtin_bit_cast(f32x4, raw[m2][bj][0]) : bf4lo(raw[m2][bj][0]), xi1 = xf32 ? __builtin_bit_cast(f32x4, raw[m2][bj][1]) : bf4hi(raw[m2][bj][0]);
                    f32x4 a0 = acc[ai][bj][m][0], a1 = acc[ai][bj][m][1];
                    if (bias) { a0 += *(const GAS f32x4*)(bias + col0 + bj * HALF); a1 += *(const GAS f32x4*)(bias + col0 + bj * HALF + 4); }
                    const f32x4 x0 = xi0 + ga[bj][0] * a0, x1 = xi1 + ga[bj][1] * a1;
                    const size_t o = row * 2048 + col0 + bj * HALF;
                    if (Xout32) { *(GAS f32x4*)(Xout32 + o) = x0; *(GAS f32x4*)(Xout32 + o + 4) = x1; }
                    else *(GAS u32x4*)(X + o) = (u32x4){cvt_pk_bf16(x0[0], x0[1]), cvt_pk_bf16(x0[2], x0[3]), cvt_pk_bf16(x1[0], x1[1]), cvt_pk_bf16(x1[2], x1[3])};
                    if (Hn) { const f32x4 h0 = x0 * gs[bj][0], h1 = x1 * gs[bj][1];
                        ss += ((x0[0] * x0[0] + x0[1] * x0[1]) + (x0[2] * x0[2] + x0[3] * x0[3])) + ((x1[0] * x1[0] + x1[1] * x1[1]) + (x1[2] * x1[2] + x1[3] * x1[3]));
                        *(GAS u32x4*)(Hn + o) = (u32x4){cvt_pk_bf16(h0[0], h0[1]), cvt_pk_bf16(h0[2], h0[3]), cvt_pk_bf16(h1[0], h1[1]), cvt_pk_bf16(h1[2], h1[3])}; }
                }
                if (Hn) { ss += __shfl_xor(ss, 16); ss += __shfl_xor(ss, 32); if (fq == 0) __hip_atomic_fetch_add(rsn + row, (unsigned long long)(ss * 1048576.0f), __ATOMIC_RELAXED, __HIP_MEMORY_SCOPE_AGENT); }
            }
            asm volatile("" ::: "memory");
        }
    }
};

template <class Epi, bool ALIGN_EPI>
__device__ __forceinline__ void gemm_phase(PG8_LAS unsigned char* lds, const Gemm g, const StaticOrder& S, const Epi& E) {
    int tid_ = threadIdx.x; asm volatile("" : "+v"(tid_));
    const int tid = tid_, wid = __builtin_amdgcn_readfirstlane(tid >> 6), lane = tid & 63, wr = wid >> 2, wc = wid & 3, fr = lane & 15, fq = lane >> 4;
    const int K = g.K, nt = K / BK;
    unsigned voffA[2], voffB[2];
#pragma unroll
    for (int i = 0; i < 2; ++i) { int R, C; stage_rc(tid * 16 + i * 8192, R, C); const int Rb = Epi::PERM ? ((R & ~31) + perm32(R & 31)) : R;
        voffA[i] = (unsigned)(R * g.lda + C) * 2u; voffB[i] = (unsigned)(Rb * g.ldb + C) * 2u; }
    const size_t kstep = (size_t)(BK * 2);
    const size_t hstepA = (size_t)HALF * g.lda * 2, hstepB = (size_t)HALF * g.ldb * 2;
    const unsigned ldsw = (unsigned)wid * 1024u;
    const int aoff = lds_byte(wr * 64 + fr, fq * 8), boff = lds_byte(wc * 32 + fr, fq * 8);
#define PG8_UA(u) ((const GAS char*)g.A + (size_t)(u).pm * 2 * hstepA + (g.agrp ? (size_t)((((u).pn * BM) / g.agrp) * g.agrp) * 2 : (size_t)0))
#define PG8_UB(u) ((const GAS char*)g.Bt + (size_t)(u).pn * 2 * hstepB)
#define PG8_SA(b, h) (((b) * 2 + (h)) * HTB)
#define PG8_SB(b, h) ((4 + (b) * 2 + (h)) * HTB)
#define PG8_STAGE(bufoff, gbase, voff) do { _Pragma("unroll") for (int _i = 0; _i < 2; ++_i) \
        __builtin_amdgcn_global_load_lds((const GAS unsigned*)((const GAS char*)(gbase) + (voff)[_i]), (PG8_LAS unsigned*)(lds + (bufoff) + ldsw + _i * 8192), 16, 0, 0); } while (0)
#define PG8_LDA(dst, b, h) do { _Pragma("unroll") for (int m = 0; m < 4; ++m) _Pragma("unroll") for (int k = 0; k < 2; ++k) dst[m][k] = *(const PG8_LAS bf16x8*)(lds + PG8_SA(b, h) + aoff + m * 2048 + k * 1024); } while (0)
#define PG8_LDB(dst, b, h) do { _Pragma("unroll") for (int n = 0; n < 2; ++n) _Pragma("unroll") for (int k = 0; k < 2; ++k) dst[n][k] = *(const PG8_LAS bf16x8*)(lds + PG8_SB(b, h) + boff + n * 2048 + k * 1024); } while (0)
#define PG8_MMA(ai, bj, At, Bt) do { __builtin_amdgcn_s_setprio(1); _Pragma("unroll") for (int m = 0; m < 4; ++m) _Pragma("unroll") for (int n = 0; n < 2; ++n) _Pragma("unroll") for (int k = 0; k < 2; ++k) \
        acc[ai][bj][m][n] = __builtin_amdgcn_mfma_f32_16x16x32_bf16(Bt[n][k], At[m][k], acc[ai][bj][m][n], 0, 0, 0); __builtin_amdgcn_s_setprio(0); } while (0)
#define PG8_WAIT_V(n) asm volatile("s_waitcnt vmcnt(" #n ")" ::: "memory")
#define PG8_WAIT_L(n) asm volatile("s_waitcnt lgkmcnt(" #n ")" ::: "memory")
#define PG8_BAR __builtin_amdgcn_s_barrier()
#define PG8_SCHED __builtin_amdgcn_sched_barrier(0)
    Unit cur, nxt; int ui = 0;
    if (!S.next(0, cur)) return;
    f32x4 acc[2][2][4][2];
#pragma unroll
    for (int a = 0; a < 2; ++a)
#pragma unroll
        for (int b = 0; b < 2; ++b)
#pragma unroll
            for (int m = 0; m < 4; ++m)
#pragma unroll
                for (int n = 0; n < 2; ++n) acc[a][b][m][n] = (f32x4){0.f, 0.f, 0.f, 0.f};
    bf16x8 At[4][2], B0[2][2], B1[2][2];
    const GAS char* cA = PG8_UA(cur); const GAS char* cB = PG8_UB(cur);
    PG8_STAGE(PG8_SB(0, 0), cB, voffB); PG8_STAGE(PG8_SB(0, 1), cB + hstepB, voffB); PG8_STAGE(PG8_SA(0, 0), cA, voffA); PG8_STAGE(PG8_SA(0, 1), cA + hstepA, voffA);
    if (wr == 1) PG8_BAR;
    PG8_WAIT_V(2); PG8_BAR;
    PG8_STAGE(PG8_SB(1, 0), cB + kstep, voffB); PG8_STAGE(PG8_SA(1, 0), cA + kstep, voffA); PG8_STAGE(PG8_SB(1, 1), cB + hstepB + kstep, voffB);
    PG8_WAIT_V(6); PG8_BAR;
    for (;;) {
        const bool has_next = S.next(ui + 1, nxt);
        const GAS char* nA = has_next ? PG8_UA(nxt) : cA; const GAS char* nB = has_next ? PG8_UB(nxt) : cB;
        for (int t = 0; t < nt; t += 2) {
            const bool last = (t == nt - 2);
            const GAS char* a1 = cA + (size_t)(t + 1) * kstep;
            const GAS char* a2 = last ? nA : cA + (size_t)(t + 2) * kstep; const GAS char* b2 = last ? nB : cB + (size_t)(t + 2) * kstep;
            const GAS char* a3 = a2 + kstep; const GAS char* b3 = b2 + kstep;
            PG8_LDB(B0, 0, 0); PG8_LDB(B1, 0, 1); PG8_SCHED; PG8_LDA(At, 0, 0); PG8_STAGE(PG8_SA(1, 1), a1 + hstepA, voffA);
            PG8_WAIT_V(8); PG8_WAIT_L(0); PG8_BAR; PG8_MMA(0, 0, At, B0); PG8_MMA(0, 1, At, B1); PG8_BAR; PG8_SCHED;
            PG8_LDA(At, 0, 1); PG8_STAGE(PG8_SB(0, 0), b2, voffB); PG8_STAGE(PG8_SB(0, 1), b2 + hstepB, voffB); PG8_STAGE(PG8_SA(0, 0), a2, voffA);
            PG8_WAIT_V(8); PG8_WAIT_L(0); PG8_BAR; PG8_MMA(1, 0, At, B0); PG8_MMA(1, 1, At, B1); PG8_BAR; PG8_SCHED;
            PG8_LDB(B0, 1, 0); PG8_LDB(B1, 1, 1); PG8_SCHED; PG8_LDA(At, 1, 0); PG8_STAGE(PG8_SA(0, 1), a2 + hstepA, voffA);
            PG8_WAIT_V(8); PG8_WAIT_L(0); PG8_BAR; PG8_MMA(0, 0, At, B0); PG8_MMA(0, 1, At, B1); PG8_BAR; PG8_SCHED;
            PG8_LDA(At, 1, 1); PG8_STAGE(PG8_SB(1, 0), b3, voffB); PG8_STAGE(PG8_SB(1, 1), b3 + hstepB, voffB); PG8_STAGE(PG8_SA(1, 0), a3, voffA);
            PG8_WAIT_V(8); PG8_WAIT_L(0); PG8_BAR; PG8_MMA(1, 0, At, B0); PG8_MMA(1, 1, At, B1); PG8_BAR; PG8_SCHED;
        }
        if constexpr (ALIGN_EPI) { if (wr == 0) PG8_BAR; }
        E(acc, cur, wr, wc, fr, fq);
        if (!has_next) break;
#pragma unroll
        for (int a = 0; a < 2; ++a)
#pragma unroll
            for (int b = 0; b < 2; ++b)
#pragma unroll
                for (int m = 0; m < 4; ++m)
#pragma unroll
                    for (int n = 0; n < 2; ++n) acc[a][b][m][n] = (f32x4){0.f, 0.f, 0.f, 0.f};
        cur = nxt; cA = nA; cB = nB; ++ui;
        if constexpr (ALIGN_EPI) { if (wr == 1) PG8_BAR; }
    }
    PG8_WAIT_V(0);
    if constexpr (!ALIGN_EPI) { if (wr == 0) PG8_BAR; }
    PG8_BAR;
#undef PG8_UA
#undef PG8_UB
#undef PG8_SA
#undef PG8_SB
#undef PG8_STAGE
#undef PG8_LDA
#undef PG8_LDB
#undef PG8_MMA
#undef PG8_WAIT_V
#undef PG8_WAIT_L
#undef PG8_BAR
#undef PG8_SCHED
}
}


namespace cg {
using pg8::f32x4; using pg8::bf16x8; using pg8::bf16_t; using pg8::cvt_pk_bf16;
using pg8::u32x2;
struct CEpiIn {
    GAS bf16_t* P; GAS float* Gl; const GAS float* lb; GAS bf16_t* QH; GAS bf16_t* KH; GAS bf16_t* VH; const GAS unsigned long long* rs; const GAS float* cb;
    __device__ __forceinline__ void apply(int row, int col, f32x4 v) const {
        const int seg = col >> 10;
        v = v * rsqrtf((float)rs[row] * (1.0f / (2048.0f * 1048576.0f)) + 1e-6f) + *(const GAS f32x4*)(cb + col);
        if (seg == 1 || seg == 2) {
            const f32x4 l4 = *(const GAS f32x4*)(lb + col - 1024); f32x4 g4;
#pragma unroll
            for (int j = 0; j < 4; ++j) { const float f = fminf(fmaxf(v[j], -60.f), 60.f), e = __expf(-f), sg = __builtin_amdgcn_rcpf(1.0f + e), l = l4[j];
                g4[j] = __logf(fmaxf(l + (1.0f - l) * sg, 1e-30f)); }
            const size_t ho = (size_t)(seg - 1) * pg8::HM_ELEMS + pg8::hm_off(row, (col >> 7) & 7) + (col & 127);
            *(GAS f32x4*)(Gl + ho) = g4;
        } else {
            if (seg == 4) {
#pragma unroll
                for (int j = 0; j < 4; ++j) v[j] = v[j] * pg8::sigmoidf_(v[j]);
            } else if (seg >= 5) v = pg8::gelu4(v);
            const u32x2 wv = (u32x2){cvt_pk_bf16(v[0], v[1]), cvt_pk_bf16(v[2], v[3])};
            if (seg == 0 || seg == 3) *(GAS u32x2*)((seg == 0 ? QH : VH) + pg8::hm_off(row, (col >> 7) & 7) + (col & 127)) = wv;
            else *(GAS u32x2*)(P + (size_t)row * 7168 + col) = wv;
        }
    }
};
template <int ACT> struct CEpiAct {
    GAS bf16_t* O; int ldc; const GAS unsigned long long* rs; const GAS float* cb;
    __device__ __forceinline__ void apply(int row, int col, f32x4 v) const {
        v = v * rsqrtf((float)rs[row] * (1.0f / (2048.0f * 1048576.0f)) + 1e-6f) + *(const GAS f32x4*)(cb + col);
        if (ACT == 1) {
#pragma unroll
            for (int j = 0; j < 4; ++j) { const float a = fmaxf(v[j], 0.f); v[j] = a * a; }
        }
        *(GAS u32x2*)(O + (size_t)row * ldc + col) = (u32x2){cvt_pk_bf16(v[0], v[1]), cvt_pk_bf16(v[2], v[3])};
    }
};
struct CEpiRes {
    GAS bf16_t* X; const GAS float* Xin; bool xf32;
    const GAS float* gate; const GAS float* bias; const GAS float* scale;
    GAS bf16_t* Hn; const GAS float* gsn; GAS unsigned long long* rsn;
    __device__ __forceinline__ void apply(int row, int col, f32x4 v) const {
        f32x4 ga = *(const GAS f32x4*)(gate + col);
        if (scale) ga = ga * *(const GAS f32x4*)(scale + col);
        if (bias) v = v + *(const GAS f32x4*)(bias + col);
        const size_t o = (size_t)row * 2048 + col;
        f32x4 xi;
        if (xf32) xi = *(const GAS f32x4*)(Xin + o);
        else { const u32x2 w = *(const GAS u32x2*)(X + o); xi = (f32x4){__builtin_bit_cast(float, w.x << 16), __builtin_bit_cast(float, w.x & 0xffff0000u), __builtin_bit_cast(float, w.y << 16), __builtin_bit_cast(float, w.y & 0xffff0000u)}; }
        const f32x4 x = xi + ga * v;
        *(GAS u32x2*)(X + o) = (u32x2){cvt_pk_bf16(x[0], x[1]), cvt_pk_bf16(x[2], x[3])};
        if (Hn) { const f32x4 h = x * *(const GAS f32x4*)(gsn + col); float ss = (x[0] * x[0] + x[1] * x[1]) + (x[2] * x[2] + x[3] * x[3]);
            *(GAS u32x2*)(Hn + o) = (u32x2){cvt_pk_bf16(h[0], h[1]), cvt_pk_bf16(h[2], h[3])};
            ss += __shfl_xor(ss, 16); ss += __shfl_xor(ss, 32); if ((threadIdx.x & 48) == 0) __hip_atomic_fetch_add(rsn + row, (unsigned long long)(ss * 1048576.0f), __ATOMIC_RELAXED, __HIP_MEMORY_SCOPE_AGENT); }
    }
};
template <class Epi>
__device__ __forceinline__ void ctx_gemm(PG8_LAS unsigned char* L, int bid, int G, const GAS bf16_t* A, int lda, const GAS bf16_t* Bt, int ldb, int n_lo, int n_hi, int K, int agrp, int row0, const Epi& E) {
    int tid_ = threadIdx.x; asm volatile("" : "+v"(tid_));
    const int w = __builtin_amdgcn_readfirstlane(tid_ >> 6), lane = tid_ & 63, q = lane >> 4, li = lane & 15;
    const int ncb = (n_hi - n_lo) >> 6, nitems = 8 * ncb, ksl = K >> 3, nst = ksl >> 6;
    const int xcd_ = bid & 7, slot_ = bid >> 3, cpp_ = G >> 6;
    for (int pass = 0; ; ++pass) {
        int rb, cb;
        if ((G & 63) == 0) { rb = slot_ & 7; cb = 8 * ((slot_ >> 3) + cpp_ * pass) + xcd_; if (8 * cpp_ * pass >= ncb) break; if (cb >= ncb) { asm volatile("" ::: "memory"); continue; } }
        else { const int item = bid + G * pass; if (item >= nitems) break; rb = item & 7; cb = item >> 3; }
        const int m0 = 64 * rb, n0 = n_lo + 64 * cb;
        const int acol = agrp ? (n0 / agrp) * agrp : 0;
        const GAS bf16_t* ap = A + (size_t)(m0 + li) * lda + acol + w * ksl + 8 * q;
        const GAS bf16_t* bp = Bt + (size_t)(n0 + li) * ldb + w * ksl + 8 * q;
        f32x4 acc[4][4];
#pragma unroll
        for (int rt = 0; rt < 4; ++rt)
#pragma unroll
            for (int ct = 0; ct < 4; ++ct) acc[rt][ct] = (f32x4){0.f, 0.f, 0.f, 0.f};
        bf16x8 a0[4][2], b0[4][2], a1[4][2], b1[4][2];
#define CG_LOAD(dA, dB, s) do { _Pragma("unroll") for (int t = 0; t < 4; ++t) _Pragma("unroll") for (int hh = 0; hh < 2; ++hh) { \
            dA[t][hh] = *(const GAS bf16x8*)(ap + (size_t)(16 * t) * lda + (s) * 64 + hh * 32); dB[t][hh] = *(const GAS bf16x8*)(bp + (size_t)(16 * t) * ldb + (s) * 64 + hh * 32); } } while (0)
#define CG_MMA(dA, dB) do { _Pragma("unroll") for (int hh = 0; hh < 2; ++hh) _Pragma("unroll") for (int rt = 0; rt < 4; ++rt) _Pragma("unroll") for (int ct = 0; ct < 4; ++ct) \
            acc[rt][ct] = __builtin_amdgcn_mfma_f32_16x16x32_bf16(dB[ct][hh], dA[rt][hh], acc[rt][ct], 0, 0, 0); } while (0)
        CG_LOAD(a0, b0, 0);
        for (int s = 0; s < nst; s += 2) {
            if (s + 1 < nst) CG_LOAD(a1, b1, s + 1);
            CG_MMA(a0, b0);
            if (s + 2 < nst) CG_LOAD(a0, b0, s + 2);
            if (s + 1 < nst) CG_MMA(a1, b1);
        }
#undef CG_LOAD
#undef CG_MMA
#pragma unroll
        for (int rt = 0; rt < 4; ++rt)
#pragma unroll
            for (int ct = 0; ct < 4; ++ct) *(PG8_LAS f32x4*)(L + ((w * 16 + rt * 4 + ct) * 64 + lane) * 16) = acc[rt][ct];
        asm volatile("s_waitcnt lgkmcnt(0)" ::: "memory"); __builtin_amdgcn_s_barrier(); asm volatile("" ::: "memory");
#pragma unroll
        for (int u = 0; u < 2; ++u) {
            const int tt = 2 * w + u, rt = tt >> 2, ct = tt & 3;
            f32x4 v = {0.f, 0.f, 0.f, 0.f};
#pragma unroll
            for (int ww = 0; ww < 8; ++ww) v = v + *(const PG8_LAS f32x4*)(L + ((ww * 16 + tt) * 64 + lane) * 16);
            E.apply(row0 + m0 + 16 * rt + li, n0 + 16 * ct + 4 * q, v);
        }
        asm volatile("s_waitcnt lgkmcnt(0)" ::: "memory"); __builtin_amdgcn_s_barrier(); asm volatile("" ::: "memory");
    }
}
}

constexpr int NWAVES = 8;
constexpr int D = 2048, SEQ = 8192, NLAT = 16384, CTXL = 256, NCTX = 512, MR = NLAT + NCTX;
constexpr int DFF = 8192, INC = 7168, NMOD = 12288;
constexpr float EPS = 1e-6f;

constexpr size_t MiB = 1u << 20;
constexpr size_t WS_CTL = 0, CTL_ZERO_BYTES = 3 * MiB;
constexpr size_t WS_RS = 1 * MiB;
constexpr size_t WS_MODS = 3 * MiB;
constexpr size_t WS_LB = 3 * MiB + 640 * 1024;
constexpr size_t WS_GS = 3 * MiB + 704 * 1024;
constexpr size_t WS_WIN = 4 * MiB;
constexpr size_t WS_WOUT = 60 * MiB;
constexpr size_t WS_WUP = 76 * MiB;
constexpr size_t WS_WDN = 204 * MiB;
constexpr size_t WS_WP = 332 * MiB;
constexpr size_t WS_WG = 348 * MiB;
constexpr size_t WS_X = 352 * MiB;
constexpr size_t WS_H = 484 * MiB;
constexpr size_t WS_P = 550 * MiB;
constexpr size_t WS_G = 781 * MiB;
constexpr size_t WS_OF = 913 * MiB;
constexpr size_t WS_OB = 979 * MiB;
constexpr size_t WS_Y = 1045 * MiB;
constexpr size_t WS_HID = 550 * MiB;
constexpr size_t WS_HS = 1111 * MiB;
constexpr size_t WS_DS = 1127 * MiB;
constexpr size_t WS_WSB = 1128 * MiB;
constexpr size_t WS_CB = 1129 * MiB;
constexpr size_t WS_QH = 1130 * MiB;
constexpr size_t WS_KH = 1163 * MiB;
constexpr size_t WS_VH = 1229 * MiB;
constexpr size_t WS_END = 1262 * MiB;
constexpr int CW_BAR = 4096;

constexpr int RING_BYTES = 131072;
constexpr int LDSCTL_OFF = RING_BYTES, MISC_OFF = LDSCTL_OFF + 320;
constexpr int LDS_BYTES = 147456;

#define LAS __attribute__((address_space(3)))
typedef unsigned short bf16;
typedef unsigned v4u __attribute__((ext_vector_type(4)));
typedef unsigned v2u __attribute__((ext_vector_type(2)));
typedef float f32x4 __attribute__((ext_vector_type(4)));
#define LDS_WAIT() asm volatile("s_waitcnt lgkmcnt(0)" ::: "memory")
__device__ __forceinline__ unsigned f2bf(float f) { unsigned u = __builtin_bit_cast(unsigned, f); return (u + 0x7fffu + ((u >> 16) & 1u)) >> 16; }
__device__ __forceinline__ unsigned pk2(float lo, float hi) { return f2bf(lo) | (f2bf(hi) << 16); }
__device__ __forceinline__ float bf2f(unsigned short b) { return __builtin_bit_cast(float, ((unsigned)b) << 16); }
__device__ __forceinline__ float bflo(unsigned w) { return __builtin_bit_cast(float, w << 16); }
__device__ __forceinline__ float bfhi(unsigned w) { return __builtin_bit_cast(float, w & 0xffff0000u); }

#define XB_TMO      128
#define XB_XCNT(j)  (256  + 64 * (j))
#define XB_XSUB(j)  (1280 + 64 * (j))
#define XB_XGEN(j)  (2304 + 64 * (j))
#define XB_TOP      3328
#define XB_TOPGEN   3392
#define XCD_BAR_WORDS 3456
#define XB_SPIN_CAP (1u << 18)
__device__ __forceinline__ unsigned xb_ld(unsigned* p)              { return __hip_atomic_load(p, __ATOMIC_RELAXED, __HIP_MEMORY_SCOPE_AGENT); }
__device__ __forceinline__ unsigned xb_add(unsigned* p, unsigned v) { return __hip_atomic_fetch_add(p, v, __ATOMIC_RELAXED, __HIP_MEMORY_SCOPE_AGENT); }
__device__ __forceinline__ unsigned xb_xcc_id() { return (unsigned)__builtin_amdgcn_s_getreg((3 << 11) | 20) & 0xFu; }
#define XB_SPIN(cond, bar) do { unsigned _sp = 0; while (cond) { __builtin_amdgcn_s_sleep(1); \
    if ((++_sp & 255u) == 0u) { if (xb_ld(&(bar)[XB_TMO])) break; if (_sp > XB_SPIN_CAP) { atomicAdd(&(bar)[XB_TMO], 1u); break; } } } } while (0)
struct XcdBarrier { unsigned* bar; unsigned x; volatile LAS unsigned* st; };
__device__ __forceinline__ XcdBarrier xcd_barrier_post(unsigned* bar, volatile LAS unsigned* st) {
    XcdBarrier b; b.bar = bar; b.x = xb_xcc_id(); b.st = st;
    if (threadIdx.x == 0) (void)xb_add(&bar[XB_XCNT(b.x)], 1u);
    return b;
}
__device__ __forceinline__ void xcd_barrier_complete(unsigned* bar, unsigned x, unsigned& nloc, unsigned& nx) {
    const unsigned G = gridDim.x * gridDim.y * gridDim.z;
    unsigned sum, cnt, mine, sp = 0u;
    for (;;) {
        sum = 0u; cnt = 0u; mine = 0u;
#pragma unroll
        for (unsigned j = 0; j < 16; ++j) { const unsigned c = xb_ld(&bar[XB_XCNT(j)]); sum += c; cnt += (c > 0u) ? 1u : 0u; mine = (j == x) ? c : mine; }
        if (sum == G) break;
        __builtin_amdgcn_s_sleep(1);
        if ((++sp & 255u) == 0u) { if (xb_ld(&bar[XB_TMO])) break; if (sp > XB_SPIN_CAP) { atomicAdd(&bar[XB_TMO], 1u); break; } }
    }
    nloc = mine > 0u ? mine : 1u; nx = cnt > 0u ? cnt : 1u;
}
__device__ __forceinline__ void xcd_barrier(const XcdBarrier& b) {
    asm volatile("s_waitcnt vmcnt(0)" ::: "memory");
    __syncthreads();
    if (threadIdx.x == 0) {
        unsigned* bar = b.bar;
        __builtin_amdgcn_s_waitcnt(0);
        unsigned nloc = b.st[0], nx = b.st[1];
        if (nloc == 0u) { xcd_barrier_complete(bar, b.x, nloc, nx); b.st[0] = nloc; b.st[1] = nx; }
        const unsigned old = xb_add(&bar[XB_XSUB(b.x)], 1u);
        const unsigned gen = old / nloc;
        if (old + 1u == (gen + 1u) * nloc) {
            __builtin_amdgcn_fence(__ATOMIC_RELEASE, "agent");
            asm volatile("s_waitcnt vmcnt(0)" ::: "memory");
            const unsigned og = xb_add(&bar[XB_TOP], 1u);
            const unsigned tg = og / nx;
            if (og + 1u == (tg + 1u) * nx) xb_add(&bar[XB_TOPGEN], 1u);
            else XB_SPIN(xb_ld(&bar[XB_TOPGEN]) == tg, bar);
            __builtin_amdgcn_fence(__ATOMIC_ACQUIRE, "agent");
            xb_add(&bar[XB_XGEN(b.x)], 1u);
            asm volatile("s_waitcnt vmcnt(0)" ::: "memory");
        } else {
            XB_SPIN(xb_ld(&bar[XB_XGEN(b.x)]) == gen, bar);
            __builtin_amdgcn_fence(__ATOMIC_ACQUIRE, "agent");
            asm volatile("s_waitcnt vmcnt(0)" ::: "memory");
        }
    }
    __syncthreads();
}

struct Frame {
    LAS unsigned char* lds;
    int tid, lane, wave, G, bid;
    GAS float* out;
    GAS unsigned char* ws;
};
struct Args { const float* in[22]; float* out; unsigned char* ws; int ph_lo, ph_hi; };
__device__ __forceinline__ const GAS float* in_ptr(int i) { unsigned long long p = (unsigned long long)__builtin_amdgcn_kernarg_segment_ptr(); asm volatile("" : "+s"(p)); return (const GAS float*)(((const __attribute__((address_space(4))) Args*)p)->in[i]); }
#define FRESH(F) do { asm volatile("" : "+v"(F.tid)); F.lane = F.tid & 63; F.wave = __builtin_amdgcn_readfirstlane(F.tid >> 6); asm volatile("" : "+s"(F.ws)); } while (0)
__device__ __forceinline__ float wave_sum(float v) {
#pragma unroll
    for (int o = 1; o < 64; o <<= 1) v += __shfl_xor(v, o);
    return v;
}

__device__ __forceinline__ void p0_transpose_item(const GAS float* W, int K, int N, GAS bf16* WT, LAS float* scr, int item, int lane) {
    const int nblk = N / 32, kb = item / nblk, nb = item % nblk, k0 = 64 * kb, n0 = 32 * nb;
#pragma unroll 8
    for (int i = 0; i < 32; ++i) { const int kk = 2 * i + (lane >> 5); scr[kk * 33 + (lane & 31)] = W[(size_t)(k0 + kk) * N + n0 + (lane & 31)]; }
    LDS_WAIT(); asm volatile("" ::: "memory");
    const int c = lane & 7;
#pragma unroll
    for (int j = 0; j < 4; ++j) { const int n = (lane >> 3) + 8 * j; const LAS float* s = scr + (8 * c) * 33 + n;
        v4u o; o.x = pk2(s[0 * 33], s[1 * 33]); o.y = pk2(s[2 * 33], s[3 * 33]); o.z = pk2(s[4 * 33], s[5 * 33]); o.w = pk2(s[6 * 33], s[7 * 33]);
        *(GAS v4u*)(WT + (size_t)(n0 + n) * K + k0 + 8 * c) = o; }
    LDS_WAIT(); asm volatile("" ::: "memory");
}

__device__ __forceinline__ void prologue_phase(Frame& F) {
    const int gw = F.bid * NWAVES + F.wave, NGW = F.G * NWAVES;
    {
        LAS float* scr = (LAS float*)(F.lds + 36864 + F.wave * 8448);
        constexpr int I_IN = (D / 64) * (INC / 32), I_SQ = (D / 64) * (D / 32), I_UP = (D / 64) * (DFF / 32), I_DN = (DFF / 64) * (D / 32), I_G = (512 / 64) * (512 / 32);
        constexpr int NITEMS = 2 * I_IN + 2 * I_SQ + 4 * I_UP + 4 * I_DN + 2 * I_SQ + 8 * I_G;
        for (int it = gw; it < NITEMS; it += NGW) {
            int r = it;
            if (r < 2 * I_IN) { const int e = r / I_IN; p0_transpose_item(in_ptr(8) + (size_t)e * D * INC, D, INC, (GAS bf16*)(F.ws + WS_WIN) + (size_t)e * INC * D, scr, r % I_IN, F.lane); continue; } r -= 2 * I_IN;
            if (r < 2 * I_SQ) { const int e = r / I_SQ; p0_transpose_item(in_ptr(9) + (size_t)e * D * D, D, D, (GAS bf16*)(F.ws + WS_WOUT) + (size_t)e * D * D, scr, r % I_SQ, F.lane); continue; } r -= 2 * I_SQ;
            if (r < 4 * I_UP) { const int l = r / I_UP; p0_transpose_item(in_ptr(19) + (size_t)l * D * DFF, D, DFF, (GAS bf16*)(F.ws + WS_WUP) + (size_t)l * DFF * D, scr, r % I_UP, F.lane); continue; } r -= 4 * I_UP;
            if (r < 4 * I_DN) { const int l = r / I_DN; p0_transpose_item(in_ptr(20) + (size_t)l * DFF * D, DFF, D, (GAS bf16*)(F.ws + WS_WDN) + (size_t)l * D * DFF, scr, r % I_DN, F.lane); continue; } r -= 4 * I_DN;
            if (r < 2 * I_SQ) { const int o = r / I_SQ; p0_transpose_item(in_ptr(15) + (size_t)o * D * D, D, D, (GAS bf16*)(F.ws + WS_WP) + (size_t)o * D * D, scr, r % I_SQ, F.lane); continue; } r -= 2 * I_SQ;
            { const int og = r / I_G; p0_transpose_item(in_ptr(16) + (size_t)og * 512 * 512, 512, 512, (GAS bf16*)(F.ws + WS_WG) + (size_t)og * 512 * 512, scr, r % I_G, F.lane); }
        }
    }
    {
        const GAS float* wsp = in_ptr(12); GAS bf16* wsb = (GAS bf16*)(F.ws + WS_WSB);
        for (int i = (F.bid * NWAVES * 64 + F.tid) * 4; i < 2 * 8 * 128 * 128; i += F.G * NWAVES * 64 * 4) { const f32x4 v = *(const GAS f32x4*)(wsp + i); *(GAS v2u*)(wsb + i) = (v2u){pk2(v[0], v[1]), pk2(v[2], v[3])}; }
    }
    if (F.bid == 0) {
        const GAS float* lg = in_ptr(10); GAS float* lb = (GAS float*)(F.ws + WS_LB);
        for (int i = F.tid; i < 2048; i += NWAVES * 64) {
            const int d = i >> 10, k = i & 1023;
            const float l0 = lg[(d * 2 + 0) * 1024 + k], l1 = lg[(d * 2 + 1) * 1024 + k], mx = fmaxf(l0, l1);
            const float e0 = expf(l0 - mx), e1 = expf(l1 - mx), p0 = e0 / (e0 + e1), p1 = e1 / (e0 + e1);
            lb[0 * 2048 + i] = p0 - p0; lb[1 * 2048 + i] = (p0 + p1) - p0;
        }
    }
    {
        LAS float* sv = (LAS float*)F.lds;
        LAS float* red = (LAS float*)(F.lds + 24576);
        for (int i = F.tid; i < 3 * D; i += NWAVES * 64) { const int r = i / D, k = i % D; const float x = r < 2 ? in_ptr(1)[r * D + k] : in_ptr(3)[k]; sv[i] = x / (1.0f + expf(-x)); }
        __syncthreads();
        GAS float* mods = (GAS float*)(F.ws + WS_MODS);
        const int cl = F.lane & 31, kh = F.lane >> 5;
        for (int item = F.bid; item < 4 * 96; item += F.G) {
            const int l = item / 96, n0 = (item % 96) * 128;
            const GAS float* W = in_ptr(4) + (size_t)l * D * NMOD + n0 + cl * 4;
            f32x4 a0 = {0.f, 0.f, 0.f, 0.f}, a1 = a0, a2 = a0;
#pragma unroll 8
            for (int i = 0; i < 128; ++i) {
                const int k = F.wave * 256 + 2 * i + kh;
                const f32x4 w4 = *(const GAS f32x4*)(W + (size_t)k * NMOD);
                a0 += sv[k] * w4; a1 += sv[D + k] * w4; a2 += sv[2 * D + k] * w4;
            }
#pragma unroll
            for (int j = 0; j < 4; ++j) { a0[j] += __shfl_xor(a0[j], 32); a1[j] += __shfl_xor(a1[j], 32); a2[j] += __shfl_xor(a2[j], 32); }
            if (F.lane < 32) { *(LAS f32x4*)(red + (F.wave * 3 + 0) * 128 + cl * 4) = a0; *(LAS f32x4*)(red + (F.wave * 3 + 1) * 128 + cl * 4) = a1; *(LAS f32x4*)(red + (F.wave * 3 + 2) * 128 + cl * 4) = a2; }
            __syncthreads();
            if (F.tid < 384) { const int r = F.tid / 128, c = F.tid % 128; float s = 0.f;
#pragma unroll
                for (int w = 0; w < 8; ++w) s += red[(w * 3 + r) * 128 + c];
                mods[(size_t)(l * 3 + r) * NMOD + n0 + c] = s + in_ptr(5)[(size_t)l * NMOD + n0 + c]; }
            __syncthreads();
        }
    }
}

__device__ __forceinline__ void prep_phase(Frame& F) {
    const int gw = F.bid * NWAVES + F.wave, NGW = F.G * NWAVES;
    const GAS float* mods = (const GAS float*)(F.ws + WS_MODS);
    {
        GAS bf16* H = (GAS bf16*)(F.ws + WS_H); GAS unsigned long long* RS = (GAS unsigned long long*)(F.ws + WS_RS);
        const GAS float* gvec = in_ptr(6);
        for (int row = gw; row < MR; row += NGW) {
            const GAS float* xr = row < NLAT ? in_ptr(0) + (size_t)row * D : in_ptr(2) + (size_t)(row - NLAT) * D;
            const int mr = row < SEQ ? 0 : (row < NLAT ? 1 : 2);
            f32x4 v[8]; float ss = 0.f;
#pragma unroll
            for (int j = 0; j < 8; ++j) { v[j] = *(const GAS f32x4*)(xr + 4 * (F.lane + 64 * j)); ss += (v[j][0] * v[j][0] + v[j][1] * v[j][1]) + (v[j][2] * v[j][2] + v[j][3] * v[j][3]); }
            ss = wave_sum(ss);
            if (F.lane == 0) RS[row] = (unsigned long long)(ss * 1048576.0f);
#pragma unroll
            for (int j = 0; j < 8; ++j) {
                const int col = 4 * (F.lane + 64 * j);
                const f32x4 g4 = *(const GAS f32x4*)(gvec + col), s4 = *(const GAS f32x4*)(mods + (size_t)mr * NMOD + 2048 + col);
                const f32x4 y = v[j] * g4 * (1.0f + s4);
                v2u w; w.x = pk2(y[0], y[1]); w.y = pk2(y[2], y[3]);
                *(GAS v2u*)(H + (size_t)row * D + col) = w;
            }
        }
    }
    {
        GAS float* GS = (GAS float*)(F.ws + WS_GS);
        for (int i = F.bid * NWAVES * 64 + F.tid; i < 4 * 2 * 3 * D; i += F.G * NWAVES * 64) {
            const int col = i % D, mr = (i / D) % 3, j = (i / (3 * D)) % 2, L = i / (6 * D);
            const float g = (j ? in_ptr(7) : in_ptr(6))[(size_t)L * D + col], sc = mods[((size_t)L * 3 + mr) * NMOD + (j ? 8192 : 2048) + col];
            GS[i] = g * (1.0f + sc);
        }
    }
    {
        GAS float* CB = (GAS float*)(F.ws + WS_CB);
        for (int L = 0; L < 4; ++L)
            for (int j = 0; j < 2; ++j) {
                const int N = j ? DFF : ((L & 1) ? D : INC);
                const GAS bf16* WT = j ? (const GAS bf16*)(F.ws + WS_WUP) + (size_t)L * DFF * D : ((L & 1) ? (const GAS bf16*)(F.ws + WS_WP) + (size_t)(L >> 1) * D * D : (const GAS bf16*)(F.ws + WS_WIN) + (size_t)(L >> 1) * INC * D);
                const GAS float* sh = mods + (size_t)L * 3 * NMOD + (j ? 6144 : 0);
                f32x4 s0[8], s1[8], s2[8];
#pragma unroll
                for (int jj = 0; jj < 4; ++jj)
#pragma unroll
                    for (int h2 = 0; h2 < 2; ++h2) { const int k = 8 * F.lane + 512 * jj + 4 * h2;
                        s0[2 * jj + h2] = *(const GAS f32x4*)(sh + k); s1[2 * jj + h2] = *(const GAS f32x4*)(sh + NMOD + k); s2[2 * jj + h2] = *(const GAS f32x4*)(sh + 2 * NMOD + k); }
                for (int n = gw; n < N; n += NGW) {
                    float a0 = 0.f, a1 = 0.f, a2 = 0.f;
                    v4u wv[4];
#pragma unroll
                    for (int jj = 0; jj < 4; ++jj) wv[jj] = *(const GAS v4u*)(WT + (size_t)n * D + 8 * F.lane + 512 * jj);
#pragma unroll
                    for (int jj = 0; jj < 4; ++jj) {
                        const float wf[8] = {bflo(wv[jj].x), bfhi(wv[jj].x), bflo(wv[jj].y), bfhi(wv[jj].y), bflo(wv[jj].z), bfhi(wv[jj].z), bflo(wv[jj].w), bfhi(wv[jj].w)};
#pragma unroll
                        for (int h2 = 0; h2 < 2; ++h2)
#pragma unroll
                            for (int u = 0; u < 4; ++u) { a0 += s0[2 * jj + h2][u] * wf[4 * h2 + u]; a1 += s1[2 * jj + h2][u] * wf[4 * h2 + u]; a2 += s2[2 * jj + h2][u] * wf[4 * h2 + u]; }
                    }
                    a0 = wave_sum(a0); a1 = wave_sum(a1); a2 = wave_sum(a2);
                    if (F.lane == 0) { GAS float* o = CB + (size_t)L * 3 * 16384 + (j ? 8192 : 0) + n; o[0] = a0; o[16384] = a1; o[2 * 16384] = a2; }
                }
            }
    }
}
__device__ __forceinline__ void final_norm_phase(Frame& F) {
    const int gw = F.bid * NWAVES + F.wave, NGW = F.G * NWAVES;
    const GAS float* gvec = in_ptr(21);
    for (int row = gw; row < NLAT; row += NGW) {
        GAS float* xr = F.out + (size_t)row * D;
        f32x4 v[8]; float ss = 0.f;
#pragma unroll
        for (int j = 0; j < 8; ++j) { v[j] = *(const GAS f32x4*)(xr + 4 * (F.lane + 64 * j)); ss += (v[j][0] * v[j][0] + v[j][1] * v[j][1]) + (v[j][2] * v[j][2] + v[j][3] * v[j][3]); }
        const float rstd = rsqrtf(wave_sum(ss) * (1.0f / D) + EPS);
#pragma unroll
        for (int j = 0; j < 8; ++j) { const int col = 4 * (F.lane + 64 * j); *(GAS f32x4*)(xr + col) = (v[j] * rstd) * *(const GAS f32x4*)(gvec + col); }
    }
}

constexpr int SC_RS = 272, SC_TS = 144;
constexpr int SC_QB = 0, SC_QS = 17408, SC_KS0 = 34816, SC_KS1 = SC_KS0 + 16 * SC_RS, SC_KS2 = SC_KS1 + 32 * SC_RS, SC_KS3 = SC_KS2 + 48 * SC_RS;
constexpr int SC_KST = SC_KS3 + 64 * SC_RS, SC_VT = SC_KST + 128 * SC_TS, SC_A = SC_VT + 128 * SC_TS, SC_TOT = SC_A + 64 * SC_TS, SC_D = SC_TOT + 4096, SC_END = SC_D + 512;
static_assert(SC_END <= RING_BYTES, "scan LDS map");
#define SC_LBAR() do { asm volatile("s_waitcnt lgkmcnt(0)" ::: "memory"); __builtin_amdgcn_s_barrier(); asm volatile("" ::: "memory"); } while (0)
typedef short bf16x8_t __attribute__((ext_vector_type(8)));
typedef float f32x2_t __attribute__((ext_vector_type(2)));
__device__ __forceinline__ unsigned cvtpk(float lo, float hi) { return pg8::cvt_pk_bf16(lo, hi); }

template <bool STATE_ONLY>
__device__ __forceinline__ void scan_fast_phase(Frame& F) {
    const GAS float* Gl = (const GAS float*)(F.ws + WS_G);
    const GAS bf16* QH = (const GAS bf16*)(F.ws + WS_QH); const GAS bf16* VH = (const GAS bf16*)(F.ws + WS_VH);
    GAS float* HS = (GAS float*)(F.ws + WS_HS); GAS float* DS = (GAS float*)(F.ws + WS_DS);
    LAS unsigned char* L = F.lds;
    const int w = F.wave, lane = F.lane, q = lane >> 4, li = lane & 15;
    if (!STATE_ONLY) { for (int u = F.tid; u < (64 * SC_TS) / 4; u += NWAVES * 64) ((LAS unsigned*)(L + SC_A))[u] = 0u; }
    for (int item = F.bid; item < 256; item += F.G) {
        const int seq = item >> 3, seg = item & 7, b = seq >> 4, h = (seq >> 1) & 7, dir = seq & 1;
        const int cs = seg < 4 ? 17 * seg : 68 + 16 * (seg - 4), ce = seg < 4 ? 17 * (seg + 1) : 68 + 16 * (seg - 3);
        f32x4 S[8];
#pragma unroll
        for (int kt = 0; kt < 8; ++kt) S[kt] = (f32x4){0.f, 0.f, 0.f, 0.f};
        if (!STATE_ONLY) {
            for (int jj = 0; jj < seg; ++jj) {
                const GAS float* hp = HS + ((size_t)((seq * 8 + jj) * 8 + w) * 64 + lane) * 32; const GAS float* dp = DS + (size_t)(seq * 8 + jj) * 128;
#pragma unroll
                for (int kt = 0; kt < 8; ++kt) { const f32x4 hv = *(const GAS f32x4*)(hp + 4 * kt), dv = *(const GAS f32x4*)(dp + 16 * kt + 4 * q); S[kt] = dv * S[kt] + hv; }
            }
        }
        float segtot0 = 0.f, segtot1 = 0.f;
        f32x2_t gx[8]; unsigned qw[8], vw[8];
#define SC_LOAD(ci_) do { const int ci__ = (ci_); const int p0 = ci__ < 4 ? 64 * ci__ : 64 * (ci__ - 4); \
        const size_t hb = ci__ < 4 ? (size_t)16 * SEQ * 128 + ((size_t)((b * 8 + h) * CTXL + (dir ? CTXL - 1 - p0 : p0))) * 128 : ((size_t)((b * 8 + h) * SEQ + (dir ? SEQ - 1 - p0 : p0))) * 128; \
        _Pragma("unroll") for (int r = 0; r < 8; ++r) { const size_t eo = dir ? hb - (size_t)(8 * w + r) * 128 + 2 * lane : hb + (size_t)(8 * w + r) * 128 + 2 * lane; \
            gx[r] = *(const GAS f32x2_t*)(Gl + (size_t)dir * pg8::HM_ELEMS + eo); \
            vw[r] = *(const GAS unsigned*)(VH + eo); \
            if (!STATE_ONLY) qw[r] = *(const GAS unsigned*)(QH + eo); } } while (0)
        SC_LOAD(cs);
        for (int ci = cs; ci < ce; ++ci) {
            float l0[8], l1[8], kf0[8], kf1[8];
            { float a0 = 0.f, a1 = 0.f;
#pragma unroll
              for (int r = 0; r < 8; ++r) { a0 += gx[r][0]; a1 += gx[r][1]; l0[r] = a0; l1[r] = a1; kf0[r] = 1.0f - __expf(gx[r][0]); kf1[r] = 1.0f - __expf(gx[r][1]); }
              *(LAS f32x2_t*)(L + SC_TOT + (w * 128 + 2 * lane) * 4) = (f32x2_t){a0, a1}; }
            SC_LBAR();
            float rr0[5], rr1[5], pre0 = 0.f, pre1 = 0.f;
            { float s0 = 0.f, s1 = 0.f; rr0[0] = 0.f; rr1[0] = 0.f;
#pragma unroll
              for (int ww = 0; ww < 8; ++ww) { const f32x2_t t = *(const LAS f32x2_t*)(L + SC_TOT + (ww * 128 + 2 * lane) * 4); if (ww == w) { pre0 = s0; pre1 = s1; } s0 += t[0]; s1 += t[1]; if (ww & 1) { rr0[(ww + 1) >> 1] = s0; rr1[(ww + 1) >> 1] = s1; } } }
            const int c = w >> 1;
            float rc0 = 0.f, rc1 = 0.f, rn0 = 0.f, rn1 = 0.f;
#pragma unroll
            for (int cc = 0; cc < 4; ++cc) if (cc == c) { rc0 = rr0[cc]; rc1 = rr1[cc]; rn0 = rr0[cc + 1]; rn1 = rr1[cc + 1]; }
            if (STATE_ONLY) {
                unsigned k0p[4], k1p[4], v0p[4], v1p[4];
#pragma unroll
                for (int r = 0; r < 8; r += 2) {
                    const float fa0 = __expf(rr0[4] - (pre0 + l0[r])), fa1 = __expf(rr1[4] - (pre1 + l1[r])), fb0 = __expf(rr0[4] - (pre0 + l0[r + 1])), fb1 = __expf(rr1[4] - (pre1 + l1[r + 1]));
                    k0p[r >> 1] = cvtpk(kf0[r] * fa0, kf0[r + 1] * fb0); k1p[r >> 1] = cvtpk(kf1[r] * fa1, kf1[r + 1] * fb1);
                    v0p[r >> 1] = (vw[r] & 0xffffu) | (vw[r + 1] << 16); v1p[r >> 1] = (vw[r] >> 16) | (vw[r + 1] & 0xffff0000u);
                }
                *(LAS v4u*)(L + SC_KST + (2 * lane) * SC_TS + 16 * w) = (v4u){k0p[0], k0p[1], k0p[2], k0p[3]}; *(LAS v4u*)(L + SC_KST + (2 * lane + 1) * SC_TS + 16 * w) = (v4u){k1p[0], k1p[1], k1p[2], k1p[3]};
                *(LAS v4u*)(L + SC_VT + (2 * lane) * SC_TS + 16 * w) = (v4u){v0p[0], v0p[1], v0p[2], v0p[3]}; *(LAS v4u*)(L + SC_VT + (2 * lane + 1) * SC_TS + 16 * w) = (v4u){v1p[0], v1p[1], v1p[2], v1p[3]};
                if (w == 0) *(LAS f32x2_t*)(L + SC_D + 8 * lane) = (f32x2_t){__expf(rr0[4]), __expf(rr1[4])};
                segtot0 += rr0[4]; segtot1 += rr1[4];
            } else {
                const float R0 = __expf(rc0), R1 = __expf(rc1);
                float T0[5], T1[5];
#pragma unroll
                for (int cp = 1; cp < 5; ++cp) { T0[cp] = __expf(rr0[cp] - rn0); T1[cp] = __expf(rr1[cp] - rn1); }
                unsigned k0p[4], k1p[4], v0p[4], v1p[4];
#pragma unroll
                for (int r = 0; r < 8; ++r) {
                    const int i = 8 * w + r;
                    const float B0 = pre0 + l0[r], B1 = pre1 + l1[r];
                    const float E0 = __expf(B0 - rc0), E1 = __expf(B1 - rc1), F0 = __expf(rn0 - B0), F1 = __expf(rn1 - B1), D0 = __expf(fminf(rc0 - B0, 80.f)), D1 = __expf(fminf(rc1 - B1, 80.f));
                    const float q0 = bflo(qw[r]) * E0, q1 = bfhi(qw[r]) * E1, k0 = kf0[r], k1 = kf1[r];
                    *(LAS unsigned*)(L + SC_QS + i * SC_RS + 4 * lane) = cvtpk(q0, q1);
                    *(LAS unsigned*)(L + SC_QB + i * SC_RS + 4 * lane) = cvtpk(q0 * R0, q1 * R1);
                    const float kf0 = k0 * F0, kf1 = k1 * F1;
                    const unsigned kd = cvtpk(k0 * D0, k1 * D1);
                    if (c == 0) { *(LAS unsigned*)(L + SC_KS0 + i * SC_RS + 4 * lane) = kd; *(LAS unsigned*)(L + SC_KS1 + i * SC_RS + 4 * lane) = cvtpk(kf0 * T0[1], kf1 * T1[1]); *(LAS unsigned*)(L + SC_KS2 + i * SC_RS + 4 * lane) = cvtpk(kf0 * T0[2], kf1 * T1[2]); *(LAS unsigned*)(L + SC_KS3 + i * SC_RS + 4 * lane) = cvtpk(kf0 * T0[3], kf1 * T1[3]); }
                    else if (c == 1) { *(LAS unsigned*)(L + SC_KS1 + i * SC_RS + 4 * lane) = kd; *(LAS unsigned*)(L + SC_KS2 + i * SC_RS + 4 * lane) = cvtpk(kf0 * T0[2], kf1 * T1[2]); *(LAS unsigned*)(L + SC_KS3 + i * SC_RS + 4 * lane) = cvtpk(kf0 * T0[3], kf1 * T1[3]); }
                    else if (c == 2) { *(LAS unsigned*)(L + SC_KS2 + i * SC_RS + 4 * lane) = kd; *(LAS unsigned*)(L + SC_KS3 + i * SC_RS + 4 * lane) = cvtpk(kf0 * T0[3], kf1 * T1[3]); }
                    else { *(LAS unsigned*)(L + SC_KS3 + i * SC_RS + 4 * lane) = kd; }
                    const float ks0 = kf0 * T0[4], ks1 = kf1 * T1[4];
                    if (r & 1) { k0p[r >> 1] |= (cvtpk(ks0, ks0) << 16); k1p[r >> 1] |= (cvtpk(ks1, ks1) << 16); v0p[r >> 1] |= (vw[r] << 16); v1p[r >> 1] |= (vw[r] & 0xffff0000u); }
                    else { k0p[r >> 1] = cvtpk(ks0, ks0) & 0xffffu; k1p[r >> 1] = cvtpk(ks1, ks1) & 0xffffu; v0p[r >> 1] = vw[r] & 0xffffu; v1p[r >> 1] = vw[r] >> 16; }
                }
                *(LAS v4u*)(L + SC_KST + (2 * lane) * SC_TS + 16 * w) = (v4u){k0p[0], k0p[1], k0p[2], k0p[3]}; *(LAS v4u*)(L + SC_KST + (2 * lane + 1) * SC_TS + 16 * w) = (v4u){k1p[0], k1p[1], k1p[2], k1p[3]};
                *(LAS v4u*)(L + SC_VT + (2 * lane) * SC_TS + 16 * w) = (v4u){v0p[0], v0p[1], v0p[2], v0p[3]}; *(LAS v4u*)(L + SC_VT + (2 * lane + 1) * SC_TS + 16 * w) = (v4u){v1p[0], v1p[1], v1p[2], v1p[3]};
                if (w == 0) *(LAS f32x2_t*)(L + SC_D + 8 * lane) = (f32x2_t){__expf(rr0[4]), __expf(rr1[4])};
            }
            const int p0c = ci < 4 ? 64 * ci : 64 * (ci - 4);
            const long orow0 = ci < 4 ? (long)NLAT + b * CTXL + (dir ? CTXL - 1 - p0c : p0c) : (long)b * SEQ + (dir ? SEQ - 1 - p0c : p0c);
            if (ci + 1 < ce) SC_LOAD(ci + 1);
            SC_LBAR();
            f32x4 O[4];
            if (!STATE_ONLY) {
#pragma unroll
                for (int rep = 0; rep < 2; ++rep) {
                    const int blk = w + 8 * rep;
                    if (blk < 10) {
                        const int cq = blk < 1 ? 0 : (blk < 3 ? 1 : (blk < 6 ? 2 : 3)), ck = blk - (cq * (cq + 1)) / 2;
                        const int ksoff = cq == 0 ? SC_KS0 : (cq == 1 ? SC_KS1 : (cq == 2 ? SC_KS2 : SC_KS3));
                        f32x4 acc = {0.f, 0.f, 0.f, 0.f};
#pragma unroll
                        for (int kk = 0; kk < 4; ++kk) {
                            const bf16x8_t a = *(const LAS bf16x8_t*)(L + ksoff + (16 * ck + li) * SC_RS + kk * 64 + q * 16);
                            const bf16x8_t bq = *(const LAS bf16x8_t*)(L + SC_QS + (16 * cq + li) * SC_RS + kk * 64 + q * 16);
                            acc = __builtin_amdgcn_mfma_f32_16x16x32_bf16(a, bq, acc, 0, 0, 0);
                        }
                        if (cq == ck) {
#pragma unroll
                            for (int r = 0; r < 4; ++r) if (4 * q + r > li) acc[r] = 0.f;
                        }
                        *(LAS v2u*)(L + SC_A + (16 * cq + li) * SC_TS + (16 * ck + 4 * q) * 2) = (v2u){cvtpk(acc[0], acc[1]), cvtpk(acc[2], acc[3])};
                    }
                }
#pragma unroll
                for (int it = 0; it < 4; ++it) O[it] = (f32x4){0.f, 0.f, 0.f, 0.f};
#pragma unroll
                for (int kk = 0; kk < 4; ++kk) {
                    const v4u sb = (v4u){cvtpk(S[2 * kk][0], S[2 * kk][1]), cvtpk(S[2 * kk][2], S[2 * kk][3]), cvtpk(S[2 * kk + 1][0], S[2 * kk + 1][1]), cvtpk(S[2 * kk + 1][2], S[2 * kk + 1][3])};
                    const bf16x8_t bs = __builtin_bit_cast(bf16x8_t, sb);
#pragma unroll
                    for (int it = 0; it < 4; ++it) {
                        const v2u a_lo = *(const LAS v2u*)(L + SC_QB + (16 * it + li) * SC_RS + kk * 64 + q * 8), a_hi = *(const LAS v2u*)(L + SC_QB + (16 * it + li) * SC_RS + kk * 64 + 32 + q * 8);
                        const bf16x8_t a = __builtin_bit_cast(bf16x8_t, (v4u){a_lo.x, a_lo.y, a_hi.x, a_hi.y});
                        O[it] = __builtin_amdgcn_mfma_f32_16x16x32_bf16(a, bs, O[it], 0, 0, 0);
                    }
                }
                SC_LBAR();
            }
            bf16x8_t bv[2];
#pragma unroll
            for (int is = 0; is < 2; ++is) bv[is] = *(const LAS bf16x8_t*)(L + SC_VT + (16 * w + li) * SC_TS + is * 64 + q * 16);
            if (!STATE_ONLY) {
#pragma unroll
                for (int it = 0; it < 4; ++it)
#pragma unroll
                    for (int ks = 0; ks < 2; ++ks) if (ks == 0 || it >= 2) {
                        const bf16x8_t a = *(const LAS bf16x8_t*)(L + SC_A + (16 * it + li) * SC_TS + ks * 64 + q * 16);
                        O[it] = __builtin_amdgcn_mfma_f32_16x16x32_bf16(a, bv[ks], O[it], 0, 0, 0);
                    }
                GAS float* Od = (GAS float*)(F.ws + (dir ? WS_OB : WS_OF));
#pragma unroll
                for (int it = 0; it < 4; ++it)
#pragma unroll
                    for (int r = 0; r < 4; ++r) { const int i = 16 * it + 4 * q + r; const long row = orow0 + (dir ? -i : i); Od[row * 1024 + h * 128 + 16 * w + li] = O[it][r]; }
            }
#pragma unroll
            for (int kt = 0; kt < 8; ++kt) {
                const f32x4 dv = *(const LAS f32x4*)(L + SC_D + (16 * kt + 4 * q) * 4);
                S[kt] = S[kt] * dv;
#pragma unroll
                for (int is = 0; is < 2; ++is) {
                    const bf16x8_t a = *(const LAS bf16x8_t*)(L + SC_KST + (16 * kt + li) * SC_TS + is * 64 + q * 16);
                    S[kt] = __builtin_amdgcn_mfma_f32_16x16x32_bf16(a, bv[is], S[kt], 0, 0, 0);
                }
            }
        }
#undef SC_LOAD
        if (STATE_ONLY) {
            GAS float* hp = HS + ((size_t)((seq * 8 + seg) * 8 + w) * 64 + lane) * 32;
#pragma unroll
            for (int kt = 0; kt < 8; ++kt) *(GAS f32x4*)(hp + 4 * kt) = S[kt];
            if (w == 0) *(GAS f32x2_t*)(DS + (size_t)(seq * 8 + seg) * 128 + 2 * lane) = (f32x2_t){__expf(segtot0), __expf(segtot1)};
        }
        SC_LBAR();
    }
}

__device__ __forceinline__ void readout_phase(Frame& F, int e, int nrows) {
    const GAS bf16* P = (const GAS bf16*)(F.ws + WS_P); GAS bf16* Y = (GAS bf16*)(F.ws + WS_Y);
    {
        const GAS float* OF = (const GAS float*)(F.ws + WS_OF); const GAS float* OB = (const GAS float*)(F.ws + WS_OB); const GAS float* ng = in_ptr(11) + (size_t)e * 1024;
        const int gw = F.bid * NWAVES + F.wave, NGW = F.G * NWAVES;
        for (int row = gw; row < nrows; row += NGW) {
            const int col = 16 * F.lane; f32x4 o[4]; float ss = 0.f;
#pragma unroll
            for (int j = 0; j < 4; ++j) { o[j] = *(const GAS f32x4*)(OF + (size_t)row * 1024 + col + 4 * j) + *(const GAS f32x4*)(OB + (size_t)row * 1024 + col + 4 * j);
                ss += (o[j][0] * o[j][0] + o[j][1] * o[j][1]) + (o[j][2] * o[j][2] + o[j][3] * o[j][3]); }
            ss += __shfl_xor(ss, 1); ss += __shfl_xor(ss, 2); ss += __shfl_xor(ss, 4);
            const float r = rsqrtf(ss * (1.0f / 128.0f) + EPS);
            const v4u s0 = *(const GAS v4u*)(P + (size_t)row * INC + 4096 + col), s1 = *(const GAS v4u*)(P + (size_t)row * INC + 4096 + col + 8);
            const float sgv[16] = {bflo(s0.x), bfhi(s0.x), bflo(s0.y), bfhi(s0.y), bflo(s0.z), bfhi(s0.z), bflo(s0.w), bfhi(s0.w), bflo(s1.x), bfhi(s1.x), bflo(s1.y), bfhi(s1.y), bflo(s1.z), bfhi(s1.z), bflo(s1.w), bfhi(s1.w)};
            float y[16];
#pragma unroll
            for (int j = 0; j < 4; ++j) { const f32x4 g4 = *(const GAS f32x4*)(ng + col + 4 * j);
#pragma unroll
                for (int q = 0; q < 4; ++q) y[4 * j + q] = o[j][q] * r * g4[q] * sgv[4 * j + q]; }
            v4u w0, w1; w0.x = pk2(y[0], y[1]); w0.y = pk2(y[2], y[3]); w0.z = pk2(y[4], y[5]); w0.w = pk2(y[6], y[7]); w1.x = pk2(y[8], y[9]); w1.y = pk2(y[10], y[11]); w1.z = pk2(y[12], y[13]); w1.w = pk2(y[14], y[15]);
            *(GAS v4u*)(Y + (size_t)row * D + col) = w0; *(GAS v4u*)(Y + (size_t)row * D + col + 8) = w1;
        }
    }
}
__device__ __forceinline__ void spatial_mfma_phase(Frame& F, int e, int nchunks) {
    const GAS bf16* P = (const GAS bf16*)(F.ws + WS_P); GAS bf16* Y = (GAS bf16*)(F.ws + WS_Y);
    LAS unsigned char* L = F.lds; constexpr int VP = 272;
    const GAS float* gv = in_ptr(14) + (size_t)e * 1024; const GAS float* bsp = in_ptr(13) + (size_t)e * 1024;
    const GAS bf16* wsb = (const GAS bf16*)(F.ws + WS_WSB) + (size_t)e * 8 * 128 * 128;
    const int w = F.wave, lane = F.lane, q = lane >> 4, li = lane & 15;
    const int nitems = nchunks * 8;
    if (F.bid >= nitems) return;
    const bool gfix = (F.G & 7) == 0; const int g0 = F.bid & 7;
    bf16x8_t wf[4];
#pragma unroll
    for (int ks = 0; ks < 4; ++ks) wf[ks] = *(const GAS bf16x8_t*)(wsb + ((size_t)g0 * 128 + 16 * w + li) * 128 + 32 * ks + 8 * q);
    unsigned xr[16];
#define SP_LOAD(item_) do { const int n_ = (item_) >> 3, g_ = (item_) & 7; const size_t rb_ = n_ < 128 ? (size_t)n_ * 128 : (size_t)NLAT + (size_t)(n_ - 128) * 128; \
        _Pragma("unroll") for (int i = 0; i < 16; ++i) xr[i] = *(const GAS unsigned*)(P + (rb_ + 16 * w + i) * INC + 6144 + g_ * 128 + 2 * lane); } while (0)
    SP_LOAD(F.bid);
    for (int item = F.bid; item < nitems; item += F.G) {
        const int n = item >> 3, g = item & 7; const size_t rowbase = n < 128 ? (size_t)n * 128 : (size_t)NLAT + (size_t)(n - 128) * 128;
        const float gva = gv[g * 128 + 2 * lane], gvb = gv[g * 128 + 2 * lane + 1];
        float s1[16], s2[16], x0[16], x1[16];
#pragma unroll
        for (int i = 0; i < 16; ++i) { x0[i] = bflo(xr[i]); x1[i] = bfhi(xr[i]); s1[i] = x0[i] + x1[i]; s2[i] = x0[i] * x0[i] + x1[i] * x1[i]; }
#pragma unroll
        for (int o = 1; o < 64; o <<= 1)
#pragma unroll
            for (int i = 0; i < 16; ++i) { s1[i] += __shfl_xor(s1[i], o); s2[i] += __shfl_xor(s2[i], o); }
#pragma unroll
        for (int i = 0; i < 16; i += 2) {
            const int s = 16 * w + i;
            const float ma = s1[i] * (1.0f / 128.0f), mb = s1[i + 1] * (1.0f / 128.0f);
            const float ra = rsqrtf(fmaxf(s2[i] * (1.0f / 128.0f) - ma * ma, 0.f) + EPS), rb = rsqrtf(fmaxf(s2[i + 1] * (1.0f / 128.0f) - mb * mb, 0.f) + EPS);
            *(LAS unsigned*)(L + (2 * lane) * VP + 2 * s) = cvtpk((x0[i] - ma) * ra * gva, (x0[i + 1] - mb) * rb * gva);
            *(LAS unsigned*)(L + (2 * lane + 1) * VP + 2 * s) = cvtpk((x1[i] - ma) * ra * gvb, (x1[i + 1] - mb) * rb * gvb);
        }
        if (item + F.G < nitems) SP_LOAD(item + F.G);
        __syncthreads();
        f32x4 acc[8];
#pragma unroll
        for (int ct = 0; ct < 8; ++ct) acc[ct] = (f32x4){0.f, 0.f, 0.f, 0.f};
#pragma unroll
        for (int ks = 0; ks < 4; ++ks) {
            const bf16x8_t wfk = gfix ? wf[ks] : *(const GAS bf16x8_t*)(wsb + ((size_t)g * 128 + 16 * w + li) * 128 + 32 * ks + 8 * q);
#pragma unroll
            for (int ct = 0; ct < 8; ++ct) {
                const bf16x8_t vf = *(const LAS bf16x8_t*)(L + (16 * ct + li) * VP + 64 * ks + 16 * q);
                acc[ct] = __builtin_amdgcn_mfma_f32_16x16x32_bf16(vf, wfk, acc[ct], 0, 0, 0);
            }
        }
        const int t = 16 * w + li; const float bias = bsp[g * 128 + t]; const size_t row = rowbase + t;
        v2u uw[8];
#pragma unroll
        for (int ct = 0; ct < 8; ++ct) uw[ct] = *(const GAS v2u*)(P + row * INC + 5120 + g * 128 + 16 * ct + 4 * q);
#pragma unroll
        for (int ct = 0; ct < 8; ++ct) {
            const int c = 16 * ct + 4 * q;
            *(GAS v2u*)(Y + row * D + 1024 + g * 128 + c) = (v2u){cvtpk(bflo(uw[ct].x) * (acc[ct][0] + bias), bfhi(uw[ct].x) * (acc[ct][1] + bias)), cvtpk(bflo(uw[ct].y) * (acc[ct][2] + bias), bfhi(uw[ct].y) * (acc[ct][3] + bias))};
        }
        __syncthreads();
    }
#undef SP_LOAD
}

__device__ __forceinline__ void pool_fast_phase(Frame& F, bool with_ctx) {
    const GAS bf16* PP = (const GAS bf16*)(F.ws + WS_P); GAS bf16* Y = (GAS bf16*)(F.ws + WS_Y);
    LAS float* vs = (LAS float*)F.lds;
    for (int br0 = F.bid; br0 < 256; br0 += F.G) {
        const int br = (F.G == 256) ? ((br0 & 7) * 32 + (br0 >> 3)) : br0;
        const int b = br >> 7, r = br & 127;
#pragma unroll 1
        for (int cblk = 0; cblk < 8; ++cblk) {
            const int g = cblk >> 1, k = 2 << g, half = k >> 1;
            const int rlo = max(r - half, 0), rhi = min(r - half + k, 128);
            unsigned lofs[4]; float s[4][8];
#pragma unroll
            for (int j = 0; j < 4; ++j) { const int idx = F.tid + 512 * j; lofs[j] = (unsigned)((b * SEQ + (idx >> 5)) * D + cblk * 256 + (idx & 31) * 8);
#pragma unroll
                for (int u = 0; u < 8; ++u) s[j][u] = 0.f; }
#pragma unroll 4
            for (int rr = rlo; rr < rhi; ++rr) {
                const unsigned ro = (unsigned)rr * (unsigned)(64 * D);
#pragma unroll
                for (int j = 0; j < 4; ++j) { const v4u x = *(const GAS v4u*)(PP + (lofs[j] + ro));
                    s[j][0] += bflo(x.x); s[j][1] += bfhi(x.x); s[j][2] += bflo(x.y); s[j][3] += bfhi(x.y); s[j][4] += bflo(x.z); s[j][5] += bfhi(x.z); s[j][6] += bflo(x.w); s[j][7] += bfhi(x.w); }
            }
#pragma unroll
            for (int j = 0; j < 4; ++j) { const int idx = F.tid + 512 * j, c = idx >> 5, vec = idx & 31;
                *(LAS f32x4*)(vs + c * 256 + vec * 8) = (f32x4){s[j][0], s[j][1], s[j][2], s[j][3]}; *(LAS f32x4*)(vs + c * 256 + vec * 8 + 4) = (f32x4){s[j][4], s[j][5], s[j][6], s[j][7]}; }
            __syncthreads();
            v4u sf[4];
#pragma unroll
            for (int j = 0; j < 4; ++j) sf[j] = *(const GAS v4u*)(PP + (lofs[j] + (unsigned)r * (unsigned)(64 * D)));
#pragma unroll
            for (int j = 0; j < 4; ++j) {
                const int idx = F.tid + 512 * j, c = idx >> 5, vec = idx & 31;
                const int clo = max(c - half, 0), chi = min(c - half + k, 64);
                f32x4 s0 = {0.f, 0.f, 0.f, 0.f}, s1 = s0;
#pragma unroll 4
                for (int cc = clo; cc < chi; ++cc) { s0 += *(const LAS f32x4*)(vs + cc * 256 + vec * 8); s1 += *(const LAS f32x4*)(vs + cc * 256 + vec * 8 + 4); }
                const float inv = 1.0f / (float)((rhi - rlo) * (chi - clo));
                v4u o; o.x = pk2(s0[0] * inv - bflo(sf[j].x), s0[1] * inv - bfhi(sf[j].x)); o.y = pk2(s0[2] * inv - bflo(sf[j].y), s0[3] * inv - bfhi(sf[j].y));
                o.z = pk2(s1[0] * inv - bflo(sf[j].z), s1[1] * inv - bfhi(sf[j].z)); o.w = pk2(s1[2] * inv - bflo(sf[j].w), s1[3] * inv - bfhi(sf[j].w));
                *(GAS v4u*)(Y + (lofs[j] + (unsigned)r * (unsigned)(64 * D))) = o;
            }
            __syncthreads();
        }
    }
    if (with_ctx) {
        const size_t total = (size_t)NCTX * 256, nthr = (size_t)F.G * NWAVES * 64;
        for (size_t idx = (size_t)F.bid * NWAVES * 64 + F.tid; idx < total; idx += nthr) {
            const int rowc = (int)(idx >> 8), col = (int)(idx & 255) * 8, g = col >> 9, k = 2 << g, half = k >> 1;
            const int b = rowc >> 8, t = rowc & 255, lo = max(t - half, 0), hi = min(t - half + k, CTXL);
            float sum[8];
#pragma unroll
            for (int j = 0; j < 8; ++j) sum[j] = 0.f;
            for (int tt = lo; tt < hi; ++tt) {
                const v4u w = *(const GAS v4u*)(PP + ((size_t)NLAT + b * CTXL + tt) * D + col);
                sum[0] += bflo(w.x); sum[1] += bfhi(w.x); sum[2] += bflo(w.y); sum[3] += bfhi(w.y); sum[4] += bflo(w.z); sum[5] += bfhi(w.z); sum[6] += bflo(w.w); sum[7] += bfhi(w.w);
            }
            const float inv = 1.0f / (float)(hi - lo);
            const size_t off = ((size_t)NLAT + rowc) * D + col;
            const v4u s = *(const GAS v4u*)(PP + off);
            v4u o; o.x = pk2(sum[0] * inv - bflo(s.x), sum[1] * inv - bfhi(s.x)); o.y = pk2(sum[2] * inv - bflo(s.y), sum[3] * inv - bfhi(s.y));
            o.z = pk2(sum[4] * inv - bflo(s.z), sum[5] * inv - bfhi(s.z)); o.w = pk2(sum[6] * inv - bflo(s.w), sum[7] * inv - bfhi(s.w));
            *(GAS v4u*)(Y + off) = o;
        }
    }
}

constexpr int N_PHASES = 31;
__global__ void __launch_bounds__(NWAVES * 64, 2) fwd(Args args) {
    extern __shared__ __attribute__((aligned(16))) unsigned char lds[];
    Frame F;
    F.lds = (LAS unsigned char*)lds;
    F.tid = threadIdx.x; F.lane = F.tid & 63; F.wave = __builtin_amdgcn_readfirstlane(F.tid >> 6);
    F.G = gridDim.x; F.bid = blockIdx.x;
    F.out = (GAS float*)args.out; F.ws = (GAS unsigned char*)args.ws;
    for (int u = F.tid; u < (LDS_BYTES - LDSCTL_OFF) / 4; u += NWAVES * 64) ((LAS unsigned*)(F.lds + LDSCTL_OFF))[u] = 0u;
    __syncthreads();
    volatile LAS unsigned* MISC = (volatile LAS unsigned*)(F.lds + MISC_OFF);
    XcdBarrier bar; bar.bar = (unsigned*)(args.ws + WS_CTL) + CW_BAR; bar.x = 0; bar.st = nullptr;
    if (!MK_PER_PHASE) bar = xcd_barrier_post((unsigned*)(args.ws + WS_CTL) + CW_BAR, MISC + 8);
    const int lo = args.ph_lo, hi = args.ph_hi;
#ifndef SITE_MASK
#define SITE_MASK 0xFFFF
#endif
#define SITE(i) ((SITE_MASK >> (i)) & 1)
#define IN(k) (lo <= (k) && (k) < hi)
#define SEAM(k, kn) do { if (!MK_PER_PHASE && IN(k) && IN(kn)) xcd_barrier(bar); } while (0)
#define WSP(T, off) ((GAS T*)(F.ws + (off)))
#define MODS_L(L) ((const GAS float*)(F.ws + WS_MODS) + (size_t)(L) * 3 * NMOD)

    if (SITE(0) && IN(0)) { FRESH(F); prologue_phase(F); }
    SEAM(0, 1);
    if (SITE(1) && IN(1)) { FRESH(F); prep_phase(F); }
    SEAM(1, 2);
#define RS_(i) (WSP(unsigned long long, WS_RS) + (size_t)(i) * MR)
#define GS_(L, j) (WSP(const float, WS_GS) + (size_t)((L) * 2 + (j)) * 3 * D)
#define CB_(L, j) (WSP(const float, WS_CB) + (size_t)(L) * 3 * 16384 + ((j) ? 8192 : 0))
    for (int L = 0; L < 4; ++L) {
        const int pb = 2 + 7 * L, e = L >> 1;
        const bool cfull = L < 2;
        if ((L & 1) == 0) {
            if (SITE(2) && IN(pb + 0)) {
                FRESH(F);
                pg8::Gemm g{WSP(bf16, WS_H), WSP(const bf16, WS_WIN) + (size_t)e * INC * D, D, D, D, 0}; pg8::StaticOrder S; S.init(NLAT / 256, INC / 256, F.G, F.bid);
                pg8::EpiIn E{WSP(bf16, WS_P), WSP(float, WS_G), WSP(const float, WS_LB) + (size_t)e * 2048, WSP(bf16, WS_QH), WSP(bf16, WS_KH), WSP(bf16, WS_VH), RS_(2 * L), CB_(L, 0)};
                pg8::gemm_phase<pg8::EpiIn, true>(F.lds, g, S, E);
                FRESH(F);
                cg::CEpiIn CE{WSP(bf16, WS_P), WSP(float, WS_G), WSP(const float, WS_LB) + (size_t)e * 2048, WSP(bf16, WS_QH), WSP(bf16, WS_KH), WSP(bf16, WS_VH), RS_(2 * L), CB_(L, 0) + 2 * 16384};
                cg::ctx_gemm<cg::CEpiIn>(F.lds, F.bid, F.G, WSP(const bf16, WS_H) + (size_t)NLAT * D, D, WSP(const bf16, WS_WIN) + (size_t)e * INC * D, D, cfull ? 0 : 1024, cfull ? INC : 4096, D, 0, NLAT, CE);
            }
            SEAM(pb + 0, pb + 1);
            if (SITE(3) && IN(pb + 1)) {
                if ((F.bid >> 3) & 1) { FRESH(F); spatial_mfma_phase(F, e, cfull ? 132 : 128); FRESH(F); scan_fast_phase<true>(F); }
                else { FRESH(F); scan_fast_phase<true>(F); FRESH(F); spatial_mfma_phase(F, e, cfull ? 132 : 128); }
            }
            SEAM(pb + 1, pb + 2);
            if (SITE(13) && IN(pb + 2)) { FRESH(F); scan_fast_phase<false>(F); }
            SEAM(pb + 2, pb + 3);
            if (SITE(4) && IN(pb + 3)) { FRESH(F); readout_phase(F, e, cfull ? MR : NLAT); }
            SEAM(pb + 3, pb + 4);
            if (SITE(5) && IN(pb + 4)) {
                FRESH(F);
                pg8::Gemm g{WSP(bf16, WS_Y), WSP(const bf16, WS_WOUT) + (size_t)e * D * D, D, D, D, 0}; pg8::StaticOrder S; S.init(NLAT / 256, D / 256, F.G, F.bid);
                pg8::EpiRes E{WSP(bf16, WS_X), in_ptr(0), L == 0, MODS_L(L) + 4096, NMOD, nullptr, nullptr, WSP(bf16, WS_H), GS_(L, 1), RS_(2 * L + 1), nullptr};
                pg8::gemm_phase<pg8::EpiRes, true>(F.lds, g, S, E);
                if (cfull) {
                    FRESH(F);
                    cg::CEpiRes CE{WSP(bf16, WS_X), in_ptr(2) - (size_t)NLAT * D, L == 0, MODS_L(L) + 2 * NMOD + 4096, nullptr, nullptr, WSP(bf16, WS_H), GS_(L, 1) + 2 * D, RS_(2 * L + 1)};
                    cg::ctx_gemm<cg::CEpiRes>(F.lds, F.bid, F.G, WSP(const bf16, WS_Y) + (size_t)NLAT * D, D, WSP(const bf16, WS_WOUT) + (size_t)e * D * D, D, 0, D, D, 0, NLAT, CE);
                }
            }
        } else {
            if (SITE(6) && IN(pb + 0)) {
                FRESH(F);
                pg8::Gemm g{WSP(bf16, WS_H), WSP(const bf16, WS_WP) + (size_t)e * D * D, D, D, D, 0}; pg8::StaticOrder S; S.init(NLAT / 256, D / 256, F.G, F.bid);
                pg8::EpiAct<0> E{WSP(bf16, WS_P), D, RS_(2 * L), CB_(L, 0)};
                pg8::gemm_phase<pg8::EpiAct<0>, true>(F.lds, g, S, E);
                if (cfull) {
                    FRESH(F);
                    cg::CEpiAct<0> CE{WSP(bf16, WS_P), D, RS_(2 * L), CB_(L, 0) + 2 * 16384};
                    cg::ctx_gemm<cg::CEpiAct<0>>(F.lds, F.bid, F.G, WSP(const bf16, WS_H) + (size_t)NLAT * D, D, WSP(const bf16, WS_WP) + (size_t)e * D * D, D, 0, D, D, 0, NLAT, CE);
                }
            }
            SEAM(pb + 0, pb + 1);
            if (SITE(7) && IN(pb + 1)) { FRESH(F); pool_fast_phase(F, cfull); }
            SEAM(pb + 1, pb + 4);
            if (SITE(8) && IN(pb + 4)) {
                FRESH(F);
                pg8::Gemm g{WSP(bf16, WS_Y), WSP(const bf16, WS_WG) + (size_t)e * D * 512, D, 512, 512, 512}; pg8::StaticOrder S; S.init(NLAT / 256, D / 256, F.G, F.bid);
                pg8::EpiRes E{WSP(bf16, WS_X), nullptr, false, MODS_L(L) + 4096, NMOD, in_ptr(17) + (size_t)e * D, in_ptr(18) + (size_t)e * D, WSP(bf16, WS_H), GS_(L, 1), RS_(2 * L + 1), nullptr};
                pg8::gemm_phase<pg8::EpiRes, true>(F.lds, g, S, E);
                if (cfull) {
                    FRESH(F);
                    cg::CEpiRes CE{WSP(bf16, WS_X), nullptr, false, MODS_L(L) + 2 * NMOD + 4096, in_ptr(17) + (size_t)e * D, in_ptr(18) + (size_t)e * D, WSP(bf16, WS_H), GS_(L, 1) + 2 * D, RS_(2 * L + 1)};
                    cg::ctx_gemm<cg::CEpiRes>(F.lds, F.bid, F.G, WSP(const bf16, WS_Y) + (size_t)NLAT * D, D, WSP(const bf16, WS_WG) + (size_t)e * D * 512, 512, 0, D, 512, 512, NLAT, CE);
                }
            }
        }
        SEAM(pb + 4, pb + 5);
        if (SITE(10) && IN(pb + 5)) {
            FRESH(F);
            pg8::Gemm g{WSP(bf16, WS_H), WSP(const bf16, WS_WUP) + (size_t)L * DFF * D, D, D, D, 0}; pg8::StaticOrder S; S.init(NLAT / 256, DFF / 256, F.G, F.bid);
            pg8::EpiAct<1> E{WSP(bf16, WS_HID), DFF, RS_(2 * L + 1), CB_(L, 1)};
            pg8::gemm_phase<pg8::EpiAct<1>, true>(F.lds, g, S, E);
            if (cfull) {
                FRESH(F);
                cg::CEpiAct<1> CE{WSP(bf16, WS_HID), DFF, RS_(2 * L + 1), CB_(L, 1) + 2 * 16384};
                cg::ctx_gemm<cg::CEpiAct<1>>(F.lds, F.bid, F.G, WSP(const bf16, WS_H) + (size_t)NLAT * D, D, WSP(const bf16, WS_WUP) + (size_t)L * DFF * D, D, 0, DFF, D, 0, NLAT, CE);
            }
        }
        SEAM(pb + 5, pb + 6);
        if (SITE(11) && IN(pb + 6)) {
            FRESH(F);
            pg8::Gemm g{WSP(bf16, WS_HID), WSP(const bf16, WS_WDN) + (size_t)L * D * DFF, DFF, DFF, DFF, 0}; pg8::StaticOrder S; S.init(NLAT / 256, D / 256, F.G, F.bid);
            pg8::EpiRes E{WSP(bf16, WS_X), nullptr, false, MODS_L(L) + 10240, NMOD, nullptr, nullptr, L < 3 ? WSP(bf16, WS_H) : (GAS bf16*)nullptr, GS_(L + 1, 0), RS_(2 * L + 2), L == 3 ? F.out : (GAS float*)nullptr};
            pg8::gemm_phase<pg8::EpiRes, true>(F.lds, g, S, E);
            if (cfull) {
                FRESH(F);
                cg::CEpiRes CE{WSP(bf16, WS_X), nullptr, false, MODS_L(L) + 2 * NMOD + 10240, nullptr, nullptr, WSP(bf16, WS_H), GS_(L + 1, 0) + 2 * D, RS_(2 * L + 2)};
                cg::ctx_gemm<cg::CEpiRes>(F.lds, F.bid, F.G, WSP(const bf16, WS_HID) + (size_t)NLAT * DFF, DFF, WSP(const bf16, WS_WDN) + (size_t)L * D * DFF, DFF, 0, D, DFF, 0, NLAT, CE);
            }
        }
        SEAM(pb + 6, pb + 7);
    }
    if (SITE(12) && IN(30)) { FRESH(F); final_norm_phase(F); }
#undef IN
#undef SEAM
}

extern "C" void kernel_launch(void* const* d_in, const int* in_sizes, int n_in, void* d_out, int out_size, void* d_ws, size_t ws_size, hipStream_t stream) {
    static int grid = 0;
    if (grid == 0) {
        if (n_in != 22 || in_sizes[0] != NLAT * D || out_size != NLAT * D || ws_size < WS_END) {
            fprintf(stderr, "kernel_launch: unexpected shapes (n_in %d, in0 %d, out %d, ws %zu, need %zu); nothing launched\n", n_in, n_in > 0 ? in_sizes[0] : -1, out_size, ws_size, (size_t)WS_END); grid = -1; return; }
        int dev = 0, cus = 0, per_cu = 0;
        if (hipGetDevice(&dev) != hipSuccess || hipDeviceGetAttribute(&cus, hipDeviceAttributeMultiprocessorCount, dev) != hipSuccess) { fprintf(stderr, "kernel_launch: device query failed\n"); grid = -1; return; }
        if (hipFuncSetAttribute((const void*)fwd, hipFuncAttributeMaxDynamicSharedMemorySize, LDS_BYTES) != hipSuccess) { fprintf(stderr, "kernel_launch: hipFuncSetAttribute failed\n"); grid = -1; return; }
        if (hipOccupancyMaxActiveBlocksPerMultiprocessor(&per_cu, (const void*)fwd, NWAVES * 64, LDS_BYTES) != hipSuccess || per_cu < 1)
            fprintf(stderr, "kernel_launch: note: occupancy query reports %d workgroups per CU\n", per_cu);
        (void)hipGetLastError();
        grid = cus;
    }
    if (grid < 0) return;
    if (hipMemsetAsync((char*)d_ws + WS_CTL, 0, CTL_ZERO_BYTES, stream) != hipSuccess) { fprintf(stderr, "kernel_launch: memset failed\n"); return; }
    Args a{};
    for (int i = 0; i < 22; ++i) a.in[i] = (const float*)d_in[i];
    a.out = (float*)d_out; a.ws = (unsigned char*)d_ws;
#if MK_PER_PHASE
    for (int ph = 0; ph < N_PHASES; ++ph) {
        if (ph >= 2 && ph <= 29) { const int L = (ph - 2) / 7, s = (ph - 2) % 7; if ((L & 1) && (s == 2 || s == 3)) continue; }
        a.ph_lo = ph; a.ph_hi = ph + 1;
        hipLaunchKernelGGL(fwd, dim3(grid), dim3(NWAVES * 64), LDS_BYTES, stream, a);
    }
#else
    a.ph_lo = 0; a.ph_hi = N_PHASES;
    hipLaunchKernelGGL(fwd, dim3(grid), dim3(NWAVES * 64), LDS_BYTES, stream, a);
#endif
    const hipError_t le = hipPeekAtLastError();
    if (le != hipSuccess) fprintf(stderr, "kernel_launch: launch failed: %s\n", hipGetErrorName(le));
}
```

```cpp
#include <hip/hip_runtime.h>
#include <cstdio>
#include <cstdint>

#ifndef MK_PER_PHASE
#define MK_PER_PHASE 0
#endif

namespace pg8 {
#define PG8_LAS __attribute__((address_space(3)))
#define GAS __attribute__((address_space(1)))
typedef unsigned short bf16_t;
typedef short bf16x8 __attribute__((ext_vector_type(8)));
typedef float f32x4 __attribute__((ext_vector_type(4)));
typedef float f32x2 __attribute__((ext_vector_type(2)));
typedef unsigned u32x4 __attribute__((ext_vector_type(4)));
typedef unsigned u32x2 __attribute__((ext_vector_type(2)));
constexpr int BM = 256, BK = 64, HALF = 128, HTB = HALF * BK * 2, STAGE_BYTES = 8 * HTB, NXCD = 8, WGM = 8;

__host__ __device__ __forceinline__ int lds_byte(int r, int c) { const int st = (r >> 4) * 2 + (c >> 5), rr = r & 15, cc = c & 31, ob = rr * 64 + cc * 2; return st * 1024 + (ob ^ (((ob >> 9) & 1) << 5)); }
__host__ __device__ __forceinline__ void stage_rc(int b, int& R, int& C) { const int st = b / 1024, sb = b % 1024, swz = sb ^ (((sb >> 9) & 1) << 5); R = (st >> 1) * 16 + swz / 64; C = (st & 1) * 32 + (swz % 64) / 2; }
__host__ __device__ __forceinline__ int perm32(int rho) { const int n = rho >> 4, i = rho & 15; return 8 * (i >> 2) + 4 * n + (i & 3); }

struct Unit { int pm, pn; };
struct Gemm { const GAS bf16_t* A; const GAS bf16_t* Bt; int lda, ldb, K, agrp; };

struct StaticOrder {
    int nM, nN, nwg, G, c;
    __host__ __device__ void init(int nM_, int nN_, int G_, int c_) { nM = nM_; nN = nN_; nwg = nM * nN; G = G_; c = c_; }
    __host__ __device__ bool next(int i, Unit& u) const {
        const long L = (long)i * G + c; if (L >= nwg) return false;
        int wgid = (int)L; { const int q = nwg / NXCD, r = nwg % NXCD, xcd = wgid % NXCD, off = wgid / NXCD; wgid = (xcd < r ? xcd * (q + 1) : r * (q + 1) + (xcd - r) * q) + off; }
        const int nig = WGM * nN, gid = wgid / nig, fm = gid * WGM, gsz = (nM - fm) < WGM ? (nM - fm) : WGM;
        u.pm = fm + ((wgid % nig) % gsz); u.pn = (wgid % nig) / gsz; return true;
    }
};

__device__ __forceinline__ unsigned cvt_pk_bf16(float lo, float hi) { unsigned r; asm volatile("v_cvt_pk_bf16_f32 %0, %1, %2" : "=v"(r) : "v"(lo), "v"(hi)); return r; }
__device__ __forceinline__ f32x2 gelu_pk(f32x2 v) {
    const f32x2 av = __builtin_elementwise_abs(v), d = av * 0.2316418882f + 1.0f;
    f32x2 t; t.x = __builtin_amdgcn_rcpf(d.x); t.y = __builtin_amdgcn_rcpf(d.y);
    f32x2 q = t * 0.5307027145f + (-0.7265760135f); q = q * t + 0.7107068705f; q = q * t + (-0.142248368f); q = q * t + 0.127414796f; q = q * t;
    const f32x2 s = (v * v) * (-0.72134752044f);
    f32x2 e; e.x = __builtin_amdgcn_exp2f(s.x); e.y = __builtin_amdgcn_exp2f(s.y);
    const f32x2 m = v * (q * e), r = v - m;
    f32x2 o; o.x = v.x < 0.f ? m.x : r.x; o.y = v.y < 0.f ? m.y : r.y; return o;
}
__device__ __forceinline__ f32x4 gelu4(f32x4 v) { const f32x2 a = gelu_pk((f32x2){v[0], v[1]}), b = gelu_pk((f32x2){v[2], v[3]}); return (f32x4){a.x, a.y, b.x, b.y}; }
__device__ __forceinline__ float sigmoidf_(float x) { return __builtin_amdgcn_rcpf(1.0f + __expf(-x)); }

__device__ __forceinline__ size_t hm_off(int r, int h) { return r < 16384 ? ((size_t)(((r >> 13) * 8 + h) * 8192 + (r & 8191))) * 128 : (size_t)16 * 8192 * 128 + ((size_t)((((r - 16384) >> 8) * 8 + h) * 256 + ((r - 16384) & 255))) * 128; }
constexpr size_t HM_ELEMS = (size_t)16 * (8192 + 256) * 128;
struct EpiIn {
    static constexpr bool PERM = true;
    GAS bf16_t* P; GAS float* Gl; const GAS float* lb;
    GAS bf16_t* QH; GAS bf16_t* KH; GAS bf16_t* VH;
    const GAS unsigned long long* rs; const GAS float* cb;
    __device__ __forceinline__ void operator()(const f32x4 (&acc)[2][2][4][2], const Unit& u, int wr, int wc, int fr, int fq) const {
        const int seg = u.pn >> 2;
        const int row0 = u.pm * BM + wr * 64 + fr, col0 = u.pn * BM + wc * 32 + 8 * fq;
        const GAS float* cbr = cb + (size_t)(u.pm < 32 ? 0 : (u.pm < 64 ? 1 : 2)) * 16384;
        if (seg == 1 || seg == 2) {
#pragma unroll
            for (int bj = 0; bj < 2; ++bj) {
                const int c = col0 + bj * HALF;
                const f32x4 l0 = *(const GAS f32x4*)(lb + c - 1024), l1 = *(const GAS f32x4*)(lb + c - 1024 + 4);
                const f32x4 c0 = *(const GAS f32x4*)(cbr + c), c1 = *(const GAS f32x4*)(cbr + c + 4);
#pragma unroll
                for (int ai = 0; ai < 2; ++ai)
#pragma unroll
                    for (int m = 0; m < 4; ++m) {
                        const size_t row = (size_t)(row0 + ai * HALF + m * 16);
                        const float rstd = rsqrtf((float)rs[row] * (1.0f / (2048.0f * 1048576.0f)) + 1e-6f);
                        f32x4 g0, g1;
#pragma unroll
                        for (int j = 0; j < 4; ++j) {
                            { const float f = fminf(fmaxf(acc[ai][bj][m][0][j] * rstd + c0[j], -60.f), 60.f), e = __expf(-f), sg = __builtin_amdgcn_rcpf(1.0f + e), l = l0[j];
                              g0[j] = __logf(fmaxf(l + (1.0f - l) * sg, 1e-30f)); }
                            { const float f = fminf(fmaxf(acc[ai][bj][m][1][j] * rstd + c1[j], -60.f), 60.f), e = __expf(-f), sg = __builtin_amdgcn_rcpf(1.0f + e), l = l1[j];
                              g1[j] = __logf(fmaxf(l + (1.0f - l) * sg, 1e-30f)); }
                        }
                        const size_t ho = (size_t)(seg - 1) * HM_ELEMS + hm_off((int)row, (c >> 7) & 7) + (c & 127);
                        *(GAS f32x4*)(Gl + ho) = g0; *(GAS f32x4*)(Gl + ho + 4) = g1;
                    }
            }
        } else {
            const int mode = (seg == 4) ? 1 : (seg >= 5 ? 2 : 0);
#pragma unroll
            for (int ai = 0; ai < 2; ++ai)
#pragma unroll
                for (int m = 0; m < 4; ++m) {
                    const size_t row = (size_t)(row0 + ai * HALF + m * 16);
                    const float rstd = rsqrtf((float)rs[row] * (1.0f / (2048.0f * 1048576.0f)) + 1e-6f);
#pragma unroll
                    for (int bj = 0; bj < 2; ++bj) {
                        f32x4 v0 = acc[ai][bj][m][0] * rstd + *(const GAS f32x4*)(cbr + col0 + bj * HALF), v1 = acc[ai][bj][m][1] * rstd + *(const GAS f32x4*)(cbr + col0 + bj * HALF + 4);
                        if (mode == 1) {
#pragma unroll
                            for (int j = 0; j < 4; ++j) { v0[j] = v0[j] * sigmoidf_(v0[j]); v1[j] = v1[j] * sigmoidf_(v1[j]); }
                        } else if (mode == 2) { v0 = gelu4(v0); v1 = gelu4(v1); }
                        u32x4 w; w.x = cvt_pk_bf16(v0[0], v0[1]); w.y = cvt_pk_bf16(v0[2], v0[3]); w.z = cvt_pk_bf16(v1[0], v1[1]); w.w = cvt_pk_bf16(v1[2], v1[3]);
                        const int c = col0 + bj * HALF;
                        if (seg == 0 || seg == 3) *(GAS u32x4*)((seg == 0 ? QH : VH) + hm_off((int)row, (c >> 7) & 7) + (c & 127)) = w;
                        else *(GAS u32x4*)(P + row * 7168 + c) = w;
                    }
                }
        }
    }
};
template <int ACT> struct EpiAct {
    static constexpr bool PERM = true;
    GAS bf16_t* O; int ldc; const GAS unsigned long long* rs; const GAS float* cb;
    __device__ __forceinline__ void operator()(const f32x4 (&acc)[2][2][4][2], const Unit& u, int wr, int wc, int fr, int fq) const {
        const int row0 = u.pm * BM + wr * 64 + fr, col0 = u.pn * BM + wc * 32 + 8 * fq;
        const GAS float* cbr = cb + (size_t)(u.pm < 32 ? 0 : (u.pm < 64 ? 1 : 2)) * 16384 + col0;
        const f32x4 cb00 = *(const GAS f32x4*)(cbr), cb01 = *(const GAS f32x4*)(cbr + 4), cb10 = *(const GAS f32x4*)(cbr + HALF), cb11 = *(const GAS f32x4*)(cbr + HALF + 4);
#pragma unroll
        for (int ai = 0; ai < 2; ++ai)
#pragma unroll
            for (int m = 0; m < 4; ++m) {
                GAS bf16_t* rowp = O + (size_t)(row0 + ai * HALF + m * 16) * ldc + col0;
                const float rstd = rsqrtf((float)rs[row0 + ai * HALF + m * 16] * (1.0f / (2048.0f * 1048576.0f)) + 1e-6f);
#pragma unroll
                for (int bj = 0; bj < 2; ++bj) {
                    f32x4 v0 = acc[ai][bj][m][0] * rstd + (bj ? cb10 : cb00), v1 = acc[ai][bj][m][1] * rstd + (bj ? cb11 : cb01);
                    if (ACT == 1) {
#pragma unroll
                        for (int j = 0; j < 4; ++j) { const float a = fmaxf(v0[j], 0.f), b = fmaxf(v1[j], 0.f); v0[j] = a * a; v1[j] = b * b; }
                    }
                    u32x4 w; w.x = cvt_pk_bf16(v0[0], v0[1]); w.y = cvt_pk_bf16(v0[2], v0[3]); w.z = cvt_pk_bf16(v1[0], v1[1]); w.w = cvt_pk_bf16(v1[2], v1[3]);
                    *(GAS u32x4*)(rowp + bj * HALF) = w;
                }
            }
    }
};
__device__ __forceinline__ f32x4 bf4lo(u32x4 w) { return (f32x4){__builtin_bit_cast(float, w.x << 16), __builtin_bit_cast(float, w.x & 0xffff0000u), __builtin_bit_cast(float, w.y << 16), __builtin_bit_cast(float, w.y & 0xffff0000u)}; }
__device__ __forceinline__ f32x4 bf4hi(u32x4 w) { return (f32x4){__builtin_bit_cast(float, w.z << 16), __builtin_bit_cast(float, w.z & 0xffff0000u), __builtin_bit_cast(float, w.w << 16), __builtin_bit_cast(float, w.w & 0xffff0000u)}; }
struct EpiRes {
    static constexpr bool PERM = true;
    GAS bf16_t* X; const GAS float* Xin; bool xf32;
    const GAS float* gate; int gstride; const GAS float* bias; const GAS float* scale;
    GAS bf16_t* Hn; const GAS float* gsn; GAS unsigned long long* rsn;
    GAS float* Xout32;
    __device__ __forceinline__ void operator()(const f32x4 (&acc)[2][2][4][2], const Unit& u, int wr, int wc, int fr, int fq) const {
        const int mr = u.pm < 32 ? 0 : (u.pm < 64 ? 1 : 2);
        const GAS float* gt = gate + (size_t)mr * gstride;
        const int row0 = u.pm * BM + wr * 64 + fr, col0 = u.pn * BM + wc * 32 + 8 * fq;
        f32x4 ga[2][2], gs[2][2];
#pragma unroll
        for (int bj = 0; bj < 2; ++bj)
#pragma unroll
            for (int n = 0; n < 2; ++n) {
                const int c = col0 + bj * HALF + 4 * n;
                gs[bj][n] = Hn ? *(const GAS f32x4*)(gsn + (size_t)mr * 2048 + c) : (f32x4){0.f, 0.f, 0.f, 0.f};
                ga[bj][n] = *(const GAS f32x4*)(gt + c);
                if (scale) ga[bj][n] = ga[bj][n] * *(const GAS f32x4*)(scale + c);
            }
#pragma unroll
        for (int ai = 0; ai < 2; ++ai)
#pragma unroll
        for (int mp = 0; mp < 4; mp += 2) {
            u32x4 raw[2][2][2];
#pragma unroll
            for (int m2 = 0; m2 < 2; ++m2)
#pragma unroll
                for (int bj = 0; bj < 2; ++bj) {
                    const size_t o = (size_t)(row0 + ai * HALF + (mp + m2) * 16) * 2048 + col0 + bj * HALF;
                    if (xf32) { raw[m2][bj][0] = *(const GAS u32x4*)(Xin + o); raw[m2][bj][1] = *(const GAS u32x4*)(Xin + o + 4); }
                    else { raw[m2][bj][0] = *(const GAS u32x4*)(X + o); raw[m2][bj][1] = raw[m2][bj][0]; }
                }
            asm volatile("" ::: "memory");
#pragma unroll
            for (int m2 = 0; m2 < 2; ++m2) {
                const int m = mp + m2;
                const size_t row = (size_t)(row0 + ai * HALF + m * 16);
                float ss = 0.f;
#pragma unroll
                for (int bj = 0; bj < 2; ++bj) {
                    const f32x4 xi0 = xf32 ? __builtin_bit_cast(f32x4, raw[m2][bj][0]) : bf4lo(raw[m2][bj][0]), xi1 = xf32 ? __builtin_bit_cast(f32x4, raw[m2][bj][1]) : bf4hi(raw[m2][bj][0]);
                    f32x4 a0 = acc[ai][bj][m][0], a1 = acc[ai][bj][m][1];
                    if (bias) { a0 += *(const GAS f32x4*)(bias + col0 + bj * HALF); a1 += *(const GAS f32x4*)(bias + col0 + bj * HALF + 4); }
                    const f32x4 x0 = xi0 + ga[bj][0] * a0, x1 = xi1 + ga[bj][1] * a1;
                    const size_t o = row * 2048 + col0 + bj * HALF;
                    if (Xout32) { *(GAS f32x4*)(Xout32 + o) = x0; *(GAS f32x4*)(Xout32 + o + 4) = x1; }
                    else *(GAS u32x4*)(X + o) = (u32x4){cvt_pk_bf16(x0[0], x0[1]), cvt_pk_bf16(x0[2], x0[3]), cvt_pk_bf16(x1[0], x1[1]), cvt_pk_bf16(x1[2], x1[3])};
                    if (Hn) { const f32x4 h0 = x0 * gs[bj][0], h1 = x1 * gs[bj][1];
                        ss += ((x0[0] * x0[0] + x0[1] * x0[1]) + (x0[2] * x0[2] + x0[3] * x0[3])) + ((x1[0] * x1[0] + x1[1] * x1[1]) + (x1[2] * x1[2] + x1[3] * x1[3]));
                        *(GAS u32x4*)(Hn + o) = (u32x4){cvt_pk_bf16(h0[0], h0[1]), cvt_pk_bf16(h0[2], h0[3]), cvt_pk_bf16(h1[0], h1[1]), cvt_pk_bf16(h1[2], h1[3])}; }
                }
                if (Hn) { ss += __shfl_xor(ss, 16); ss += __shfl_xor(ss, 32); if (fq == 0) __hip_atomic_fetch_add(rsn + row, (unsigned long long)(ss * 1048576.0f), __ATOMIC_RELAXED, __HIP_MEMORY_SCOPE_AGENT); }
            }
            asm volatile("" ::: "memory");
        }
    }
};

template <class Epi, bool ALIGN_EPI>
__device__ __forceinline__ void gemm_phase(PG8_LAS unsigned char* lds, const Gemm g, const StaticOrder& S, const Epi& E) {
    int tid_ = threadIdx.x; asm volatile("" : "+v"(tid_));
    const int tid = tid_, wid = __builtin_amdgcn_readfirstlane(tid >> 6), lane = tid & 63, wr = wid >> 2, wc = wid & 3, fr = lane & 15, fq = lane >> 4;
    const int K = g.K, nt = K / BK;
    unsigned voffA[2], voffB[2];
#pragma unroll
    for (int i = 0; i < 2; ++i) { int R, C; stage_rc(tid * 16 + i * 8192, R, C); const int Rb = Epi::PERM ? ((R & ~31) + perm32(R & 31)) : R;
        voffA[i] = (unsigned)(R * g.lda + C) * 2u; voffB[i] = (unsigned)(Rb * g.ldb + C) * 2u; }
    const size_t kstep = (size_t)(BK * 2);
    const size_t hstepA = (size_t)HALF * g.lda * 2, hstepB = (size_t)HALF * g.ldb * 2;
    const unsigned ldsw = (unsigned)wid * 1024u;
    const int aoff = lds_byte(wr * 64 + fr, fq * 8), boff = lds_byte(wc * 32 + fr, fq * 8);
#define PG8_UA(u) ((const GAS char*)g.A + (size_t)(u).pm * 2 * hstepA + (g.agrp ? (size_t)((((u).pn * BM) / g.agrp) * g.agrp) * 2 : (size_t)0))
#define PG8_UB(u) ((const GAS char*)g.Bt + (size_t)(u).pn * 2 * hstepB)
#define PG8_SA(b, h) (((b) * 2 + (h)) * HTB)
#define PG8_SB(b, h) ((4 + (b) * 2 + (h)) * HTB)
#define PG8_STAGE(bufoff, gbase, voff) do { _Pragma("unroll") for (int _i = 0; _i < 2; ++_i) \
        __builtin_amdgcn_global_load_lds((const GAS unsigned*)((const GAS char*)(gbase) + (voff)[_i]), (PG8_LAS unsigned*)(lds + (bufoff) + ldsw + _i * 8192), 16, 0, 0); } while (0)
#define PG8_LDA(dst, b, h) do { _Pragma("unroll") for (int m = 0; m < 4; ++m) _Pragma("unroll") for (int k = 0; k < 2; ++k) dst[m][k] = *(const PG8_LAS bf16x8*)(lds + PG8_SA(b, h) + aoff + m * 2048 + k * 1024); } while (0)
#define PG8_LDB(dst, b, h) do { _Pragma("unroll") for (int n = 0; n < 2; ++n) _Pragma("unroll") for (int k = 0; k < 2; ++k) dst[n][k] = *(const PG8_LAS bf16x8*)(lds + PG8_SB(b, h) + boff + n * 2048 + k * 1024); } while (0)
#define PG8_MMA(ai, bj, At, Bt) do { __builtin_amdgcn_s_setprio(1); _Pragma("unroll") for (int m = 0; m < 4; ++m) _Pragma("unroll") for (int n = 0; n < 2; ++n) _Pragma("unroll") for (int k = 0; k < 2; ++k) \
        acc[ai][bj][m][n] = __builtin_amdgcn_mfma_f32_16x16x32_bf16(Bt[n][k], At[m][k], acc[ai][bj][m][n], 0, 0, 0); __builtin_amdgcn_s_setprio(0); } while (0)
#define PG8_WAIT_V(n) asm volatile("s_waitcnt vmcnt(" #n ")" ::: "memory")
#define PG8_WAIT_L(n) asm volatile("s_waitcnt lgkmcnt(" #n ")" ::: "memory")
#define PG8_BAR __builtin_amdgcn_s_barrier()
#define PG8_SCHED __builtin_amdgcn_sched_barrier(0)
    Unit cur, nxt; int ui = 0;
    if (!S.next(0, cur)) return;
    f32x4 acc[2][2][4][2];
#pragma unroll
    for (int a = 0; a < 2; ++a)
#pragma unroll
        for (int b = 0; b < 2; ++b)
#pragma unroll
            for (int m = 0; m < 4; ++m)
#pragma unroll
                for (int n = 0; n < 2; ++n) acc[a][b][m][n] = (f32x4){0.f, 0.f, 0.f, 0.f};
    bf16x8 At[4][2], B0[2][2], B1[2][2];
    const GAS char* cA = PG8_UA(cur); const GAS char* cB = PG8_UB(cur);
    PG8_STAGE(PG8_SB(0, 0), cB, voffB); PG8_STAGE(PG8_SB(0, 1), cB + hstepB, voffB); PG8_STAGE(PG8_SA(0, 0), cA, voffA); PG8_STAGE(PG8_SA(0, 1), cA + hstepA, voffA);
    if (wr == 1) PG8_BAR;
    PG8_WAIT_V(2); PG8_BAR;
    PG8_STAGE(PG8_SB(1, 0), cB + kstep, voffB); PG8_STAGE(PG8_SA(1, 0), cA + kstep, voffA); PG8_STAGE(PG8_SB(1, 1), cB + hstepB + kstep, voffB);
    PG8_WAIT_V(6); PG8_BAR;
    for (;;) {
        const bool has_next = S.next(ui + 1, nxt);
        const GAS char* nA = has_next ? PG8_UA(nxt) : cA; const GAS char* nB = has_next ? PG8_UB(nxt) : cB;
        for (int t = 0; t < nt; t += 2) {
            const bool last = (t == nt - 2);
            const GAS char* a1 = cA + (size_t)(t + 1) * kstep;
            const GAS char* a2 = last ? nA : cA + (size_t)(t + 2) * kstep; const GAS char* b2 = last ? nB : cB + (size_t)(t + 2) * kstep;
            const GAS char* a3 = a2 + kstep; const GAS char* b3 = b2 + kstep;
            PG8_LDB(B0, 0, 0); PG8_LDB(B1, 0, 1); PG8_SCHED; PG8_LDA(At, 0, 0); PG8_STAGE(PG8_SA(1, 1), a1 + hstepA, voffA);
            PG8_WAIT_V(8); PG8_WAIT_L(0); PG8_BAR; PG8_MMA(0, 0, At, B0); PG8_MMA(0, 1, At, B1); PG8_BAR; PG8_SCHED;
            PG8_LDA(At, 0, 1); PG8_STAGE(PG8_SB(0, 0), b2, voffB); PG8_STAGE(PG8_SB(0, 1), b2 + hstepB, voffB); PG8_STAGE(PG8_SA(0, 0), a2, voffA);
            PG8_WAIT_V(8); PG8_WAIT_L(0); PG8_BAR; PG8_MMA(1, 0, At, B0); PG8_MMA(1, 1, At, B1); PG8_BAR; PG8_SCHED;
            PG8_LDB(B0, 1, 0); PG8_LDB(B1, 1, 1); PG8_SCHED; PG8_LDA(At, 1, 0); PG8_STAGE(PG8_SA(0, 1), a2 + hstepA, voffA);
            PG8_WAIT_V(8); PG8_WAIT_L(0); PG8_BAR; PG8_MMA(0, 0, At, B0); PG8_MMA(0, 1, At, B1); PG8_BAR; PG8_SCHED;
            PG8_LDA(At, 1, 1); PG8_STAGE(PG8_SB(1, 0), b3, voffB); PG8_STAGE(PG8_SB(1, 1), b3 + hstepB, voffB); PG8_STAGE(PG8_SA(1, 0), a3, voffA);
            PG8_WAIT_V(8); PG8_WAIT_L(0); PG8_BAR; PG8_MMA(1, 0, At, B0); PG8_MMA(1, 1, At, B1); PG8_BAR; PG8_SCHED;
        }
        if constexpr (ALIGN_EPI) { if (wr == 0) PG8_BAR; }
        E(acc, cur, wr, wc, fr, fq);
        if (!has_next) break;
#pragma unroll
        for (int a = 0; a < 2; ++a)
#pragma unroll
            for (int b = 0; b < 2; ++b)
#pragma unroll
                for (int m = 0; m < 4; ++m)
#pragma unroll
                    for (int n = 0; n < 2; ++n) acc[a][b][m][n] = (f32x4){0.f, 0.f, 0.f, 0.f};
        cur = nxt; cA = nA; cB = nB; ++ui;
        if constexpr (ALIGN_EPI) { if (wr == 1) PG8_BAR; }
    }
    PG8_WAIT_V(0);
    if constexpr (!ALIGN_EPI) { if (wr == 0) PG8_BAR; }
    PG8_BAR;
#undef PG8_UA
#undef PG8_UB
#undef PG8_SA
#undef PG8_SB
#undef PG8_STAGE
#undef PG8_LDA
#undef PG8_LDB
#undef PG8_MMA
#undef PG8_WAIT_V
#undef PG8_WAIT_L
#undef PG8_BAR
#undef PG8_SCHED
}
}


namespace cg {
using pg8::f32x4; using pg8::bf16x8; using pg8::bf16_t; using pg8::cvt_pk_bf16;
using pg8::u32x2;
struct CEpiIn {
    GAS bf16_t* P; GAS float* Gl; const GAS float* lb; GAS bf16_t* QH; GAS bf16_t* KH; GAS bf16_t* VH; const GAS unsigned long long* rs; const GAS float* cb;
    __device__ __forceinline__ void apply(int row, int col, f32x4 v) const {
        const int seg = col >> 10;
        v = v * rsqrtf((float)rs[row] * (1.0f / (2048.0f * 1048576.0f)) + 1e-6f) + *(const GAS f32x4*)(cb + col);
        if (seg == 1 || seg == 2) {
            const f32x4 l4 = *(const GAS f32x4*)(lb + col - 1024); f32x4 g4;
#pragma unroll
            for (int j = 0; j < 4; ++j) { const float f = fminf(fmaxf(v[j], -60.f), 60.f), e = __expf(-f), sg = __builtin_amdgcn_rcpf(1.0f + e), l = l4[j];
                g4[j] = __logf(fmaxf(l + (1.0f - l) * sg, 1e-30f)); }
            const size_t ho = (size_t)(seg - 1) * pg8::HM_ELEMS + pg8::hm_off(row, (col >> 7) & 7) + (col & 127);
            *(GAS f32x4*)(Gl + ho) = g4;
        } else {
            if (seg == 4) {
#pragma unroll
                for (int j = 0; j < 4; ++j) v[j] = v[j] * pg8::sigmoidf_(v[j]);
            } else if (seg >= 5) v = pg8::gelu4(v);
            const u32x2 wv = (u32x2){cvt_pk_bf16(v[0], v[1]), cvt_pk_bf16(v[2], v[3])};
            if (seg == 0 || seg == 3) *(GAS u32x2*)((seg == 0 ? QH : VH) + pg8::hm_off(row, (col >> 7) & 7) + (col & 127)) = wv;
            else *(GAS u32x2*)(P + (size_t)row * 7168 + col) = wv;
        }
    }
};
template <int ACT> struct CEpiAct {
    GAS bf16_t* O; int ldc; const GAS unsigned long long* rs; const GAS float* cb;
    __device__ __forceinline__ void apply(int row, int col, f32x4 v) const {
        v = v * rsqrtf((float)rs[row] * (1.0f / (2048.0f * 1048576.0f)) + 1e-6f) + *(const GAS f32x4*)(cb + col);
        if (ACT == 1) {
#pragma unroll
            for (int j = 0; j < 4; ++j) { const float a = fmaxf(v[j], 0.f); v[j] = a * a; }
        }
        *(GAS u32x2*)(O + (size_t)row * ldc + col) = (u32x2){cvt_pk_bf16(v[0], v[1]), cvt_pk_bf16(v[2], v[3])};
    }
};
struct CEpiRes {
    GAS bf16_t* X; const GAS float* Xin; bool xf32;
    const GAS float* gate; const GAS float* bias; const GAS float* scale;
    GAS bf16_t* Hn; const GAS float* gsn; GAS unsigned long long* rsn;
    __device__ __forceinline__ void apply(int row, int col, f32x4 v) const {
        f32x4 ga = *(const GAS f32x4*)(gate + col);
        if (scale) ga = ga * *(const GAS f32x4*)(scale + col);
        if (bias) v = v + *(const GAS f32x4*)(bias + col);
        const size_t o = (size_t)row * 2048 + col;
        f32x4 xi;
        if (xf32) xi = *(const GAS f32x4*)(Xin + o);
        else { const u32x2 w = *(const GAS u32x2*)(X + o); xi = (f32x4){__builtin_bit_cast(float, w.x << 16), __builtin_bit_cast(float, w.x & 0xffff0000u), __builtin_bit_cast(float, w.y << 16), __builtin_bit_cast(float, w.y & 0xffff0000u)}; }
        const f32x4 x = xi + ga * v;
        *(GAS u32x2*)(X + o) = (u32x2){cvt_pk_bf16(x[0], x[1]), cvt_pk_bf16(x[2], x[3])};
        if (Hn) { const f32x4 h = x * *(const GAS f32x4*)(gsn + col); float ss = (x[0] * x[0] + x[1] * x[1]) + (x[2] * x[2] + x[3] * x[3]);
            *(GAS u32x2*)(Hn + o) = (u32x2){cvt_pk_bf16(h[0], h[1]), cvt_pk_bf16(h[2], h[3])};
            ss += __shfl_xor(ss, 16); ss += __shfl_xor(ss, 32); if ((threadIdx.x & 48) == 0) __hip_atomic_fetch_add(rsn + row, (unsigned long long)(ss * 1048576.0f), __ATOMIC_RELAXED, __HIP_MEMORY_SCOPE_AGENT); }
    }
};
template <class Epi>
__device__ __forceinline__ void ctx_gemm(PG8_LAS unsigned char* L, int bid, int G, const GAS bf16_t* A, int lda, const GAS bf16_t* Bt, int ldb, int n_lo, int n_hi, int K, int agrp, int row0, const Epi& E) {
    int tid_ = threadIdx.x; asm volatile("" : "+v"(tid_));
    const int w = __builtin_amdgcn_readfirstlane(tid_ >> 6), lane = tid_ & 63, q = lane >> 4, li = lane & 15;
    const int ncb = (n_hi - n_lo) >> 6, nitems = 8 * ncb, ksl = K >> 3, nst = ksl >> 6;
    const int xcd_ = bid & 7, slot_ = bid >> 3, cpp_ = G >> 6;
    for (int pass = 0; ; ++pass) {
        int rb, cb;
        if ((G & 63) == 0) { rb = slot_ & 7; cb = 8 * ((slot_ >> 3) + cpp_ * pass) + xcd_; if (8 * cpp_ * pass >= ncb) break; if (cb >= ncb) { asm volatile("" ::: "memory"); continue; } }
        else { const int item = bid + G * pass; if (item >= nitems) break; rb = item & 7; cb = item >> 3; }
        const int m0 = 64 * rb, n0 = n_lo + 64 * cb;
        const int acol = agrp ? (n0 / agrp) * agrp : 0;
        const GAS bf16_t* ap = A + (size_t)(m0 + li) * lda + acol + w * ksl + 8 * q;
        const GAS bf16_t* bp = Bt + (size_t)(n0 + li) * ldb + w * ksl + 8 * q;
        f32x4 acc[4][4];
#pragma unroll
        for (int rt = 0; rt < 4; ++rt)
#pragma unroll
            for (int ct = 0; ct < 4; ++ct) acc[rt][ct] = (f32x4){0.f, 0.f, 0.f, 0.f};
        bf16x8 a0[4][2], b0[4][2], a1[4][2], b1[4][2];
#define CG_LOAD(dA, dB, s) do { _Pragma("unroll") for (int t = 0; t < 4; ++t) _Pragma("unroll") for (int hh = 0; hh < 2; ++hh) { \
            dA[t][hh] = *(const GAS bf16x8*)(ap + (size_t)(16 * t) * lda + (s) * 64 + hh * 32); dB[t][hh] = *(const GAS bf16x8*)(bp + (size_t)(16 * t) * ldb + (s) * 64 + hh * 32); } } while (0)
#define CG_MMA(dA, dB) do { _Pragma("unroll") for (int hh = 0; hh < 2; ++hh) _Pragma("unroll") for (int rt = 0; rt < 4; ++rt) _Pragma("unroll") for (int ct = 0; ct < 4; ++ct) \
            acc[rt][ct] = __builtin_amdgcn_mfma_f32_16x16x32_bf16(dB[ct][hh], dA[rt][hh], acc[rt][ct], 0, 0, 0); } while (0)
        CG_LOAD(a0, b0, 0);
        for (int s = 0; s < nst; s += 2) {
            if (s + 1 < nst) CG_LOAD(a1, b1, s + 1);
            CG_MMA(a0, b0);
            if (s + 2 < nst) CG_LOAD(a0, b0, s + 2);
            if (s + 1 < nst) CG_MMA(a1, b1);
        }
#undef CG_LOAD
#undef CG_MMA
#pragma unroll
        for (int rt = 0; rt < 4; ++rt)
#pragma unroll
            for (int ct = 0; ct < 4; ++ct) *(PG8_LAS f32x4*)(L + ((w * 16 + rt * 4 + ct) * 64 + lane) * 16) = acc[rt][ct];
        asm volatile("s_waitcnt lgkmcnt(0)" ::: "memory"); __builtin_amdgcn_s_barrier(); asm volatile("" ::: "memory");
#pragma unroll
        for (int u = 0; u < 2; ++u) {
            const int tt = 2 * w + u, rt = tt >> 2, ct = tt & 3;
            f32x4 v = {0.f, 0.f, 0.f, 0.f};
#pragma unroll
            for (int ww = 0; ww < 8; ++ww) v = v + *(const PG8_LAS f32x4*)(L + ((ww * 16 + tt) * 64 + lane) * 16);
            E.apply(row0 + m0 + 16 * rt + li, n0 + 16 * ct + 4 * q, v);
        }
        asm volatile("s_waitcnt lgkmcnt(0)" ::: "memory"); __builtin_amdgcn_s_barrier(); asm volatile("" ::: "memory");
    }
}
}

constexpr int NWAVES = 8;
constexpr int D = 2048, SEQ = 8192, NLAT = 16384, CTXL = 256, NCTX = 512, MR = NLAT + NCTX;
constexpr int DFF = 8192, INC = 7168, NMOD = 12288;
constexpr float EPS = 1e-6f;

constexpr size_t MiB = 1u << 20;
constexpr size_t WS_CTL = 0, CTL_ZERO_BYTES = 3 * MiB;
constexpr size_t WS_RS = 1 * MiB;
constexpr size_t WS_MODS = 3 * MiB;
constexpr size_t WS_LB = 3 * MiB + 640 * 1024;
constexpr size_t WS_GS = 3 * MiB + 704 * 1024;
constexpr size_t WS_WIN = 4 * MiB;
constexpr size_t WS_WOUT = 60 * MiB;
constexpr size_t WS_WUP = 76 * MiB;
constexpr size_t WS_WDN = 204 * MiB;
constexpr size_t WS_WP = 332 * MiB;
constexpr size_t WS_WG = 348 * MiB;
constexpr size_t WS_X = 352 * MiB;
constexpr size_t WS_H = 484 * MiB;
constexpr size_t WS_P = 550 * MiB;
constexpr size_t WS_G = 781 * MiB;
constexpr size_t WS_OF = 913 * MiB;
constexpr size_t WS_OB = 979 * MiB;
constexpr size_t WS_Y = 1045 * MiB;
constexpr size_t WS_HID = 550 * MiB;
constexpr size_t WS_HS = 1111 * MiB;
constexpr size_t WS_DS = 1127 * MiB;
constexpr size_t WS_WSB = 1128 * MiB;
constexpr size_t WS_CB = 1129 * MiB;
constexpr size_t WS_QH = 1130 * MiB;
constexpr size_t WS_KH = 1163 * MiB;
constexpr size_t WS_VH = 1229 * MiB;
constexpr size_t WS_END = 1262 * MiB;
constexpr int CW_BAR = 4096;

constexpr int RING_BYTES = 131072;
constexpr int LDSCTL_OFF = RING_BYTES, MISC_OFF = LDSCTL_OFF + 320;
constexpr int LDS_BYTES = 147456;

#define LAS __attribute__((address_space(3)))
typedef unsigned short bf16;
typedef unsigned v4u __attribute__((ext_vector_type(4)));
typedef unsigned v2u __attribute__((ext_vector_type(2)));
typedef float f32x4 __attribute__((ext_vector_type(4)));
#define LDS_WAIT() asm volatile("s_waitcnt lgkmcnt(0)" ::: "memory")
__device__ __forceinline__ unsigned f2bf(float f) { unsigned u = __builtin_bit_cast(unsigned, f); return (u + 0x7fffu + ((u >> 16) & 1u)) >> 16; }
__device__ __forceinline__ unsigned pk2(float lo, float hi) { return f2bf(lo) | (f2bf(hi) << 16); }
__device__ __forceinline__ float bf2f(unsigned short b) { return __builtin_bit_cast(float, ((unsigned)b) << 16); }
__device__ __forceinline__ float bflo(unsigned w) { return __builtin_bit_cast(float, w << 16); }
__device__ __forceinline__ float bfhi(unsigned w) { return __builtin_bit_cast(float, w & 0xffff0000u); }

#define XB_TMO      128
#define XB_XCNT(j)  (256  + 64 * (j))
#define XB_XSUB(j)  (1280 + 64 * (j))
#define XB_XGEN(j)  (2304 + 64 * (j))
#define XB_TOP      3328
#define XB_TOPGEN   3392
#define XCD_BAR_WORDS 3456
#define XB_SPIN_CAP (1u << 18)
__device__ __forceinline__ unsigned xb_ld(unsigned* p)              { return __hip_atomic_load(p, __ATOMIC_RELAXED, __HIP_MEMORY_SCOPE_AGENT); }
__device__ __forceinline__ unsigned xb_add(unsigned* p, unsigned v) { return __hip_atomic_fetch_add(p, v, __ATOMIC_RELAXED, __HIP_MEMORY_SCOPE_AGENT); }
__device__ __forceinline__ unsigned xb_xcc_id() { return (unsigned)__builtin_amdgcn_s_getreg((3 << 11) | 20) & 0xFu; }
#define XB_SPIN(cond, bar) do { unsigned _sp = 0; while (cond) { __builtin_amdgcn_s_sleep(1); \
    if ((++_sp & 255u) == 0u) { if (xb_ld(&(bar)[XB_TMO])) break; if (_sp > XB_SPIN_CAP) { atomicAdd(&(bar)[XB_TMO], 1u); break; } } } } while (0)
struct XcdBarrier { unsigned* bar; unsigned x; volatile LAS unsigned* st; };
__device__ __forceinline__ XcdBarrier xcd_barrier_post(unsigned* bar, volatile LAS unsigned* st) {
    XcdBarrier b; b.bar = bar; b.x = xb_xcc_id(); b.st = st;
    if (threadIdx.x == 0) (void)xb_add(&bar[XB_XCNT(b.x)], 1u);
    return b;
}
__device__ __forceinline__ void xcd_barrier_complete(unsigned* bar, unsigned x, unsigned& nloc, unsigned& nx) {
    const unsigned G = gridDim.x * gridDim.y * gridDim.z;
    unsigned sum, cnt, mine, sp = 0u;
    for (;;) {
        sum = 0u; cnt = 0u; mine = 0u;
#pragma unroll
        for (unsigned j = 0; j < 16; ++j) { const unsigned c = xb_ld(&bar[XB_XCNT(j)]); sum += c; cnt += (c > 0u) ? 1u : 0u; mine = (j == x) ? c : mine; }
        if (sum == G) break;
        __builtin_amdgcn_s_sleep(1);
        if ((++sp & 255u) == 0u) { if (xb_ld(&bar[XB_TMO])) break; if (sp > XB_SPIN_CAP) { atomicAdd(&bar[XB_TMO], 1u); break; } }
    }
    nloc = mine > 0u ? mine : 1u; nx = cnt > 0u ? cnt : 1u;
}
__device__ __forceinline__ void xcd_barrier(const XcdBarrier& b) {
    asm volatile("s_waitcnt vmcnt(0)" ::: "memory");
    __syncthreads();
    if (threadIdx.x == 0) {
        unsigned* bar = b.bar;
        __builtin_amdgcn_s_waitcnt(0);
        unsigned nloc = b.st[0], nx = b.st[1];
        if (nloc == 0u) { xcd_barrier_complete(bar, b.x, nloc, nx); b.st[0] = nloc; b.st[1] = nx; }
        const unsigned old = xb_add(&bar[XB_XSUB(b.x)], 1u);
        const unsigned gen = old / nloc;
        if (old + 1u == (gen + 1u) * nloc) {
            __builtin_amdgcn_fence(__ATOMIC_RELEASE, "agent");
            asm volatile("s_waitcnt vmcnt(0)" ::: "memory");
            const unsigned og = xb_add(&bar[XB_TOP], 1u);
            const unsigned tg = og / nx;
            if (og + 1u == (tg + 1u) * nx) xb_add(&bar[XB_TOPGEN], 1u);
            else XB_SPIN(xb_ld(&bar[XB_TOPGEN]) == tg, bar);
            __builtin_amdgcn_fence(__ATOMIC_ACQUIRE, "agent");
            xb_add(&bar[XB_XGEN(b.x)], 1u);
            asm volatile("s_waitcnt vmcnt(0)" ::: "memory");
        } else {
            XB_SPIN(xb_ld(&bar[XB_XGEN(b.x)]) == gen, bar);
            __builtin_amdgcn_fence(__ATOMIC_ACQUIRE, "agent");
            asm volatile("s_waitcnt vmcnt(0)" ::: "memory");
        }
    }
    __syncthreads();
}

struct Frame {
    LAS unsigned char* lds;
    int tid, lane, wave, G, bid;
    GAS float* out;
    GAS unsigned char* ws;
};
struct Args { const float* in[22]; float* out; unsigned char* ws; int ph_lo, ph_hi; };
__device__ __forceinline__ const GAS float* in_ptr(int i) { unsigned long long p = (unsigned long long)__builtin_amdgcn_kernarg_segment_ptr(); asm volatile("" : "+s"(p)); return (const GAS float*)(((const __attribute__((address_space(4))) Args*)p)->in[i]); }
#define FRESH(F) do { asm volatile("" : "+v"(F.tid)); F.lane = F.tid & 63; F.wave = __builtin_amdgcn_readfirstlane(F.tid >> 6); asm volatile("" : "+s"(F.ws)); } while (0)
__device__ __forceinline__ float wave_sum(float v) {
#pragma unroll
    for (int o = 1; o < 64; o <<= 1) v += __shfl_xor(v, o);
    return v;
}

__device__ __forceinline__ void p0_transpose_item(const GAS float* W, int K, int N, GAS bf16* WT, LAS float* scr, int item, int lane) {
    const int nblk = N / 32, kb = item / nblk, nb = item % nblk, k0 = 64 * kb, n0 = 32 * nb;
#pragma unroll 8
    for (int i = 0; i < 32; ++i) { const int kk = 2 * i + (lane >> 5); scr[kk * 33 + (lane & 31)] = W[(size_t)(k0 + kk) * N + n0 + (lane & 31)]; }
    LDS_WAIT(); asm volatile("" ::: "memory");
    const int c = lane & 7;
#pragma unroll
    for (int j = 0; j < 4; ++j) { const int n = (lane >> 3) + 8 * j; const LAS float* s = scr + (8 * c) * 33 + n;
        v4u o; o.x = pk2(s[0 * 33], s[1 * 33]); o.y = pk2(s[2 * 33], s[3 * 33]); o.z = pk2(s[4 * 33], s[5 * 33]); o.w = pk2(s[6 * 33], s[7 * 33]);
        *(GAS v4u*)(WT + (size_t)(n0 + n) * K + k0 + 8 * c) = o; }
    LDS_WAIT(); asm volatile("" ::: "memory");
}

__device__ __forceinline__ void prologue_phase(Frame& F) {
    const int gw = F.bid * NWAVES + F.wave, NGW = F.G * NWAVES;
    {
        LAS float* scr = (LAS float*)(F.lds + 36864 + F.wave * 8448);
        constexpr int I_IN = (D / 64) * (INC / 32), I_SQ = (D / 64) * (D / 32), I_UP = (D / 64) * (DFF / 32), I_DN = (DFF / 64) * (D / 32), I_G = (512 / 64) * (512 / 32);
        constexpr int NITEMS = 2 * I_IN + 2 * I_SQ + 4 * I_UP + 4 * I_DN + 2 * I_SQ + 8 * I_G;
        for (int it = gw; it < NITEMS; it += NGW) {
            int r = it;
            if (r < 2 * I_IN) { const int e = r / I_IN; p0_transpose_item(in_ptr(8) + (size_t)e * D * INC, D, INC, (GAS bf16*)(F.ws + WS_WIN) + (size_t)e * INC * D, scr, r % I_IN, F.lane); continue; } r -= 2 * I_IN;
            if (r < 2 * I_SQ) { const int e = r / I_SQ; p0_transpose_item(in_ptr(9) + (size_t)e * D * D, D, D, (GAS bf16*)(F.ws + WS_WOUT) + (size_t)e * D * D, scr, r % I_SQ, F.lane); continue; } r -= 2 * I_SQ;
            if (r < 4 * I_UP) { const int l = r / I_UP; p0_transpose_item(in_ptr(19) + (size_t)l * D * DFF, D, DFF, (GAS bf16*)(F.ws + WS_WUP) + (size_t)l * DFF * D, scr, r % I_UP, F.lane); continue; } r -= 4 * I_UP;
            if (r < 4 * I_DN) { const int l = r / I_DN; p0_transpose_item(in_ptr(20) + (size_t)l * DFF * D, DFF, D, (GAS bf16*)(F.ws + WS_WDN) + (size_t)l * D * DFF, scr, r % I_DN, F.lane); continue; } r -= 4 * I_DN;
            if (r < 2 * I_SQ) { const int o = r / I_SQ; p0_transpose_item(in_ptr(15) + (size_t)o * D * D, D, D, (GAS bf16*)(F.ws + WS_WP) + (size_t)o * D * D, scr, r % I_SQ, F.lane); continue; } r -= 2 * I_SQ;
            { const int og = r / I_G; p0_transpose_item(in_ptr(16) + (size_t)og * 512 * 512, 512, 512, (GAS bf16*)(F.ws + WS_WG) + (size_t)og * 512 * 512, scr, r % I_G, F.lane); }
        }
    }
    {
        const GAS float* wsp = in_ptr(12); GAS bf16* wsb = (GAS bf16*)(F.ws + WS_WSB);
        for (int i = (F.bid * NWAVES * 64 + F.tid) * 4; i < 2 * 8 * 128 * 128; i += F.G * NWAVES * 64 * 4) { const f32x4 v = *(const GAS f32x4*)(wsp + i); *(GAS v2u*)(wsb + i) = (v2u){pk2(v[0], v[1]), pk2(v[2], v[3])}; }
    }
    if (F.bid == 0) {
        const GAS float* lg = in_ptr(10); GAS float* lb = (GAS float*)(F.ws + WS_LB);
        for (int i = F.tid; i < 2048; i += NWAVES * 64) {
            const int d = i >> 10, k = i & 1023;
            const float l0 = lg[(d * 2 + 0) * 1024 + k], l1 = lg[(d * 2 + 1) * 1024 + k], mx = fmaxf(l0, l1);
            const float e0 = expf(l0 - mx), e1 = expf(l1 - mx), p0 = e0 / (e0 + e1), p1 = e1 / (e0 + e1);
            lb[0 * 2048 + i] = p0 - p0; lb[1 * 2048 + i] = (p0 + p1) - p0;
        }
    }
    {
        LAS float* sv = (LAS float*)F.lds;
        LAS float* red = (LAS float*)(F.lds + 24576);
        for (int i = F.tid; i < 3 * D; i += NWAVES * 64) { const int r = i / D, k = i % D; const float x = r < 2 ? in_ptr(1)[r * D + k] : in_ptr(3)[k]; sv[i] = x / (1.0f + expf(-x)); }
        __syncthreads();
        GAS float* mods = (GAS float*)(F.ws + WS_MODS);
        const int cl = F.lane & 31, kh = F.lane >> 5;
        for (int item = F.bid; item < 4 * 96; item += F.G) {
            const int l = item / 96, n0 = (item % 96) * 128;
            const GAS float* W = in_ptr(4) + (size_t)l * D * NMOD + n0 + cl * 4;
            f32x4 a0 = {0.f, 0.f, 0.f, 0.f}, a1 = a0, a2 = a0;
#pragma unroll 8
            for (int i = 0; i < 128; ++i) {
                const int k = F.wave * 256 + 2 * i + kh;
                const f32x4 w4 = *(const GAS f32x4*)(W + (size_t)k * NMOD);
                a0 += sv[k] * w4; a1 += sv[D + k] * w4; a2 += sv[2 * D + k] * w4;
            }
#pragma unroll
            for (int j = 0; j < 4; ++j) { a0[j] += __shfl_xor(a0[j], 32); a1[j] += __shfl_xor(a1[j], 32); a2[j] += __shfl_xor(a2[j], 32); }
            if (F.lane < 32) { *(LAS f32x4*)(red + (F.wave * 3 + 0) * 128 + cl * 4) = a0; *(LAS f32x4*)(red + (F.wave * 3 + 1) * 128 + cl * 4) = a1; *(LAS f32x4*)(red + (F.wave * 3 + 2) * 128 + cl * 4) = a2; }
            __syncthreads();
            if (F.tid < 384) { const int r = F.tid / 128, c = F.tid % 128; float s = 0.f;
#pragma unroll
                for (int w = 0; w < 8; ++w) s += red[(w * 3 + r) * 128 + c];
                mods[(size_t)(l * 3 + r) * NMOD + n0 + c] = s + in_ptr(5)[(size_t)l * NMOD + n0 + c]; }
            __syncthreads();
        }
    }
}

__device__ __forceinline__ void prep_phase(Frame& F) {
    const int gw = F.bid * NWAVES + F.wave, NGW = F.G * NWAVES;
    const GAS float* mods = (const GAS float*)(F.ws + WS_MODS);
    {
        GAS bf16* H = (GAS bf16*)(F.ws + WS_H); GAS unsigned long long* RS = (GAS unsigned long long*)(F.ws + WS_RS);
        const GAS float* gvec = in_ptr(6);
        for (int row = gw; row < MR; row += NGW) {
            const GAS float* xr = row < NLAT ? in_ptr(0) + (size_t)row * D : in_ptr(2) + (size_t)(row - NLAT) * D;
            const int mr = row < SEQ ? 0 : (row < NLAT ? 1 : 2);
            f32x4 v[8]; float ss = 0.f;
#pragma unroll
            for (int j = 0; j < 8; ++j) { v[j] = *(const GAS f32x4*)(xr + 4 * (F.lane + 64 * j)); ss += (v[j][0] * v[j][0] + v[j][1] * v[j][1]) + (v[j][2] * v[j][2] + v[j][3] * v[j][3]); }
            ss = wave_sum(ss);
            if (F.lane == 0) RS[row] = (unsigned long long)(ss * 1048576.0f);
#pragma unroll
            for (int j = 0; j < 8; ++j) {
                const int col = 4 * (F.lane + 64 * j);
                const f32x4 g4 = *(const GAS f32x4*)(gvec + col), s4 = *(const GAS f32x4*)(mods + (size_t)mr * NMOD + 2048 + col);
                const f32x4 y = v[j] * g4 * (1.0f + s4);
                v2u w; w.x = pk2(y[0], y[1]); w.y = pk2(y[2], y[3]);
                *(GAS v2u*)(H + (size_t)row * D + col) = w;
            }
        }
    }
    {
        GAS float* GS = (GAS float*)(F.ws + WS_GS);
        for (int i = F.bid * NWAVES * 64 + F.tid; i < 4 * 2 * 3 * D; i += F.G * NWAVES * 64) {
            const int col = i % D, mr = (i / D) % 3, j = (i / (3 * D)) % 2, L = i / (6 * D);
            const float g = (j ? in_ptr(7) : in_ptr(6))[(size_t)L * D + col], sc = mods[((size_t)L * 3 + mr) * NMOD + (j ? 8192 : 2048) + col];
            GS[i] = g * (1.0f + sc);
        }
    }
    {
        GAS float* CB = (GAS float*)(F.ws + WS_CB);
        for (int L = 0; L < 4; ++L)
            for (int j = 0; j < 2; ++j) {
                const int N = j ? DFF : ((L & 1) ? D : INC);
                const GAS bf16* WT = j ? (const GAS bf16*)(F.ws + WS_WUP) + (size_t)L * DFF * D : ((L & 1) ? (const GAS bf16*)(F.ws + WS_WP) + (size_t)(L >> 1) * D * D : (const GAS bf16*)(F.ws + WS_WIN) + (size_t)(L >> 1) * INC * D);
                const GAS float* sh = mods + (size_t)L * 3 * NMOD + (j ? 6144 : 0);
                f32x4 s0[8], s1[8], s2[8];
#pragma unroll
                for (int jj = 0; jj < 4; ++jj)
#pragma unroll
                    for (int h2 = 0; h2 < 2; ++h2) { const int k = 8 * F.lane + 512 * jj + 4 * h2;
                        s0[2 * jj + h2] = *(const GAS f32x4*)(sh + k); s1[2 * jj + h2] = *(const GAS f32x4*)(sh + NMOD + k); s2[2 * jj + h2] = *(const GAS f32x4*)(sh + 2 * NMOD + k); }
                for (int n = gw; n < N; n += NGW) {
                    float a0 = 0.f, a1 = 0.f, a2 = 0.f;
                    v4u wv[4];
#pragma unroll
                    for (int jj = 0; jj < 4; ++jj) wv[jj] = *(const GAS v4u*)(WT + (size_t)n * D + 8 * F.lane + 512 * jj);
#pragma unroll
                    for (int jj = 0; jj < 4; ++jj) {
                        const float wf[8] = {bflo(wv[jj].x), bfhi(wv[jj].x), bflo(wv[jj].y), bfhi(wv[jj].y), bflo(wv[jj].z), bfhi(wv[jj].z), bflo(wv[jj].w), bfhi(wv[jj].w)};
#pragma unroll
                        for (int h2 = 0; h2 < 2; ++h2)
#pragma unroll
                            for (int u = 0; u < 4; ++u) { a0 += s0[2 * jj + h2][u] * wf[4 * h2 + u]; a1 += s1[2 * jj + h2][u] * wf[4 * h2 + u]; a2 += s2[2 * jj + h2][u] * wf[4 * h2 + u]; }
                    }
                    a0 = wave_sum(a0); a1 = wave_sum(a1); a2 = wave_sum(a2);
                    if (F.lane == 0) { GAS float* o = CB + (size_t)L * 3 * 16384 + (j ? 8192 : 0) + n; o[0] = a0; o[16384] = a1; o[2 * 16384] = a2; }
                }
            }
    }
}
__device__ __forceinline__ void final_norm_phase(Frame& F) {
    const int gw = F.bid * NWAVES + F.wave, NGW = F.G * NWAVES;
    const GAS float* gvec = in_ptr(21);
    for (int row = gw; row < NLAT; row += NGW) {
        GAS float* xr = F.out + (size_t)row * D;
        f32x4 v[8]; float ss = 0.f;
#pragma unroll
        for (int j = 0; j < 8; ++j) { v[j] = *(const GAS f32x4*)(xr + 4 * (F.lane + 64 * j)); ss += (v[j][0] * v[j][0] + v[j][1] * v[j][1]) + (v[j][2] * v[j][2] + v[j][3] * v[j][3]); }
        const float rstd = rsqrtf(wave_sum(ss) * (1.0f / D) + EPS);
#pragma unroll
        for (int j = 0; j < 8; ++j) { const int col = 4 * (F.lane + 64 * j); *(GAS f32x4*)(xr + col) = (v[j] * rstd) * *(const GAS f32x4*)(gvec + col); }
    }
}

constexpr int SC_RS = 272, SC_TS = 144;
constexpr int SC_QB = 0, SC_QS = 17408, SC_KS0 = 34816, SC_KS1 = SC_KS0 + 16 * SC_RS, SC_KS2 = SC_KS1 + 32 * SC_RS, SC_KS3 = SC_KS2 + 48 * SC_RS;
constexpr int SC_KST = SC_KS3 + 64 * SC_RS, SC_VT = SC_KST + 128 * SC_TS, SC_A = SC_VT + 128 * SC_TS, SC_TOT = SC_A + 64 * SC_TS, SC_D = SC_TOT + 4096, SC_END = SC_D + 512;
static_assert(SC_END <= RING_BYTES, "scan LDS map");
#define SC_LBAR() do { asm volatile("s_waitcnt lgkmcnt(0)" ::: "memory"); __builtin_amdgcn_s_barrier(); asm volatile("" ::: "memory"); } while (0)
typedef short bf16x8_t __attribute__((ext_vector_type(8)));
typedef float f32x2_t __attribute__((ext_vector_type(2)));
__device__ __forceinline__ unsigned cvtpk(float lo, float hi) { return pg8::cvt_pk_bf16(lo, hi); }

template <bool STATE_ONLY>
__device__ __forceinline__ void scan_fast_phase(Frame& F) {
    const GAS float* Gl = (const GAS float*)(F.ws + WS_G);
    const GAS bf16* QH = (const GAS bf16*)(F.ws + WS_QH); const GAS bf16* VH = (const GAS bf16*)(F.ws + WS_VH);
    GAS float* HS = (GAS float*)(F.ws + WS_HS); GAS float* DS = (GAS float*)(F.ws + WS_DS);
    LAS unsigned char* L = F.lds;
    const int w = F.wave, lane = F.lane, q = lane >> 4, li = lane & 15;
    if (!STATE_ONLY) { for (int u = F.tid; u < (64 * SC_TS) / 4; u += NWAVES * 64) ((LAS unsigned*)(L + SC_A))[u] = 0u; }
    for (int item = F.bid; item < 256; item += F.G) {
        const int seq = item >> 3, seg = item & 7, b = seq >> 4, h = (seq >> 1) & 7, dir = seq & 1;
        const int cs = seg < 4 ? 17 * seg : 68 + 16 * (seg - 4), ce = seg < 4 ? 17 * (seg + 1) : 68 + 16 * (seg - 3);
        f32x4 S[8];
#pragma unroll
        for (int kt = 0; kt < 8; ++kt) S[kt] = (f32x4){0.f, 0.f, 0.f, 0.f};
        if (!STATE_ONLY) {
            for (int jj = 0; jj < seg; ++jj) {
                const GAS float* hp = HS + ((size_t)((seq * 8 + jj) * 8 + w) * 64 + lane) * 32; const GAS float* dp = DS + (size_t)(seq * 8 + jj) * 128;
#pragma unroll
                for (int kt = 0; kt < 8; ++kt) { const f32x4 hv = *(const GAS f32x4*)(hp + 4 * kt), dv = *(const GAS f32x4*)(dp + 16 * kt + 4 * q); S[kt] = dv * S[kt] + hv; }
            }
        }
        float segtot0 = 0.f, segtot1 = 0.f;
        f32x2_t gx[8]; unsigned qw[8], vw[8];
#define SC_LOAD(ci_) do { const int ci__ = (ci_); const int p0 = ci__ < 4 ? 64 * ci__ : 64 * (ci__ - 4); \
        const size_t hb = ci__ < 4 ? (size_t)16 * SEQ * 128 + ((size_t)((b * 8 + h) * CTXL + (dir ? CTXL - 1 - p0 : p0))) * 128 : ((size_t)((b * 8 + h) * SEQ + (dir ? SEQ - 1 - p0 : p0))) * 128; \
        _Pragma("unroll") for (int r = 0; r < 8; ++r) { const size_t eo = dir ? hb - (size_t)(8 * w + r) * 128 + 2 * lane : hb + (size_t)(8 * w + r) * 128 + 2 * lane; \
            gx[r] = *(const GAS f32x2_t*)(Gl + (size_t)dir * pg8::HM_ELEMS + eo); \
            vw[r] = *(const GAS unsigned*)(VH + eo); \
            if (!STATE_ONLY) qw[r] = *(const GAS unsigned*)(QH + eo); } } while (0)
        SC_LOAD(cs);
        for (int ci = cs; ci < ce; ++ci) {
            float l0[8], l1[8], kf0[8], kf1[8];
            { float a0 = 0.f, a1 = 0.f;
#pragma unroll
              for (int r = 0; r < 8; ++r) { a0 += gx[r][0]; a1 += gx[r][1]; l0[r] = a0; l1[r] = a1; kf0[r] = 1.0f - __expf(gx[r][0]); kf1[r] = 1.0f - __expf(gx[r][1]); }
              *(LAS f32x2_t*)(L + SC_TOT + (w * 128 + 2 * lane) * 4) = (f32x2_t){a0, a1}; }
            SC_LBAR();
            float rr0[5], rr1[5], pre0 = 0.f, pre1 = 0.f;
            { float s0 = 0.f, s1 = 0.f; rr0[0] = 0.f; rr1[0] = 0.f;
#pragma unroll
              for (int ww = 0; ww < 8; ++ww) { const f32x2_t t = *(const LAS f32x2_t*)(L + SC_TOT + (ww * 128 + 2 * lane) * 4); if (ww == w) { pre0 = s0; pre1 = s1; } s0 += t[0]; s1 += t[1]; if (ww & 1) { rr0[(ww + 1) >> 1] = s0; rr1[(ww + 1) >> 1] = s1; } } }
            const int c = w >> 1;
            float rc0 = 0.f, rc1 = 0.f, rn0 = 0.f, rn1 = 0.f;
#pragma unroll
            for (int cc = 0; cc < 4; ++cc) if (cc == c) { rc0 = rr0[cc]; rc1 = rr1[cc]; rn0 = rr0[cc + 1]; rn1 = rr1[cc + 1]; }
            if (STATE_ONLY) {
                unsigned k0p[4], k1p[4], v0p[4], v1p[4];
#pragma unroll
                for (int r = 0; r < 8; r += 2) {
                    const float fa0 = __expf(rr0[4] - (pre0 + l0[r])), fa1 = __expf(rr1[4] - (pre1 + l1[r])), fb0 = __expf(rr0[4] - (pre0 + l0[r + 1])), fb1 = __expf(rr1[4] - (pre1 + l1[r + 1]));
                    k0p[r >> 1] = cvtpk(kf0[r] * fa0, kf0[r + 1] * fb0); k1p[r >> 1] = cvtpk(kf1[r] * fa1, kf1[r + 1] * fb1);
                    v0p[r >> 1] = (vw[r] & 0xffffu) | (vw[r + 1] << 16); v1p[r >> 1] = (vw[r] >> 16) | (vw[r + 1] & 0xffff0000u);
                }
                *(LAS v4u*)(L + SC_KST + (2 * lane) * SC_TS + 16 * w) = (v4u){k0p[0], k0p[1], k0p[2], k0p[3]}; *(LAS v4u*)(L + SC_KST + (2 * lane + 1) * SC_TS + 16 * w) = (v4u){k1p[0], k1p[1], k1p[2], k1p[3]};
                *(LAS v4u*)(L + SC_VT + (2 * lane) * SC_TS + 16 * w) = (v4u){v0p[0], v0p[1], v0p[2], v0p[3]}; *(LAS v4u*)(L + SC_VT + (2 * lane + 1) * SC_TS + 16 * w) = (v4u){v1p[0], v1p[1], v1p[2], v1p[3]};
                if (w == 0) *(LAS f32x2_t*)(L + SC_D + 8 * lane) = (f32x2_t){__expf(rr0[4]), __expf(rr1[4])};
                segtot0 += rr0[4]; segtot1 += rr1[4];
            } else {
                const float R0 = __expf(rc0), R1 = __expf(rc1);
                float T0[5], T1[5];
#pragma unroll
                for (int cp = 1; cp < 5; ++cp) { T0[cp] = __expf(rr0[cp] - rn0); T1[cp] = __expf(rr1[cp] - rn1); }
                unsigned k0p[4], k1p[4], v0p[4], v1p[4];
#pragma unroll
                for (int r = 0; r < 8; ++r) {
                    const int i = 8 * w + r;
                    const float B0 = pre0 + l0[r], B1 = pre1 + l1[r];
                    const float E0 = __expf(B0 - rc0), E1 = __expf(B1 - rc1), F0 = __expf(rn0 - B0), F1 = __expf(rn1 - B1), D0 = __expf(fminf(rc0 - B0, 80.f)), D1 = __expf(fminf(rc1 - B1, 80.f));
                    const float q0 = bflo(qw[r]) * E0, q1 = bfhi(qw[r]) * E1, k0 = kf0[r], k1 = kf1[r];
                    *(LAS unsigned*)(L + SC_QS + i * SC_RS + 4 * lane) = cvtpk(q0, q1);
                    *(LAS unsigned*)(L + SC_QB + i * SC_RS + 4 * lane) = cvtpk(q0 * R0, q1 * R1);
                    const float kf0 = k0 * F0, kf1 = k1 * F1;
                    const unsigned kd = cvtpk(k0 * D0, k1 * D1);
                    if (c == 0) { *(LAS unsigned*)(L + SC_KS0 + i * SC_RS + 4 * lane) = kd; *(LAS unsigned*)(L + SC_KS1 + i * SC_RS + 4 * lane) = cvtpk(kf0 * T0[1], kf1 * T1[1]); *(LAS unsigned*)(L + SC_KS2 + i * SC_RS + 4 * lane) = cvtpk(kf0 * T0[2], kf1 * T1[2]); *(LAS unsigned*)(L + SC_KS3 + i * SC_RS + 4 * lane) = cvtpk(kf0 * T0[3], kf1 * T1[3]); }
                    else if (c == 1) { *(LAS unsigned*)(L + SC_KS1 + i * SC_RS + 4 * lane) = kd; *(LAS unsigned*)(L + SC_KS2 + i * SC_RS + 4 * lane) = cvtpk(kf0 * T0[2], kf1 * T1[2]); *(LAS unsigned*)(L + SC_KS3 + i * SC_RS + 4 * lane) = cvtpk(kf0 * T0[3], kf1 * T1[3]); }
                    else if (c == 2) { *(LAS unsigned*)(L + SC_KS2 + i * SC_RS + 4 * lane) = kd; *(LAS unsigned*)(L + SC_KS3 + i * SC_RS + 4 * lane) = cvtpk(kf0 * T0[3], kf1 * T1[3]); }
                    else { *(LAS unsigned*)(L + SC_KS3 + i * SC_RS + 4 * lane) = kd; }
                    const float ks0 = kf0 * T0[4], ks1 = kf1 * T1[4];
                    if (r & 1) { k0p[r >> 1] |= (cvtpk(ks0, ks0) << 16); k1p[r >> 1] |= (cvtpk(ks1, ks1) << 16); v0p[r >> 1] |= (vw[r] << 16); v1p[r >> 1] |= (vw[r] & 0xffff0000u); }
                    else { k0p[r >> 1] = cvtpk(ks0, ks0) & 0xffffu; k1p[r >> 1] = cvtpk(ks1, ks1) & 0xffffu; v0p[r >> 1] = vw[r] & 0xffffu; v1p[r >> 1] = vw[r] >> 16; }
                }
                *(LAS v4u*)(L + SC_KST + (2 * lane) * SC_TS + 16 * w) = (v4u){k0p[0], k0p[1], k0p[2], k0p[3]}; *(LAS v4u*)(L + SC_KST + (2 * lane + 1) * SC_TS + 16 * w) = (v4u){k1p[0], k1p[1], k1p[2], k1p[3]};
                *(LAS v4u*)(L + SC_VT + (2 * lane) * SC_TS + 16 * w) = (v4u){v0p[0], v0p[1], v0p[2], v0p[3]}; *(LAS v4u*)(L + SC_VT + (2 * lane + 1) * SC_TS + 16 * w) = (v4u){v1p[0], v1p[1], v1p[2], v1p[3]};
                if (w == 0) *(LAS f32x2_t*)(L + SC_D + 8 * lane) = (f32x2_t){__expf(rr0[4]), __expf(rr1[4])};
            }
            const int p0c = ci < 4 ? 64 * ci : 64 * (ci - 4);
            const long orow0 = ci < 4 ? (long)NLAT + b * CTXL + (dir ? CTXL - 1 - p0c : p0c) : (long)b * SEQ + (dir ? SEQ - 1 - p0c : p0c);
            if (ci + 1 < ce) SC_LOAD(ci + 1);
            SC_LBAR();
            f32x4 O[4];
            if (!STATE_ONLY) {
#pragma unroll
                for (int rep = 0; rep < 2; ++rep) {
                    const int blk = w + 8 * rep;
                    if (blk < 10) {
                        const int cq = blk < 1 ? 0 : (blk < 3 ? 1 : (blk < 6 ? 2 : 3)), ck = blk - (cq * (cq + 1)) / 2;
                        const int ksoff = cq == 0 ? SC_KS0 : (cq == 1 ? SC_KS1 : (cq == 2 ? SC_KS2 : SC_KS3));
                        f32x4 acc = {0.f, 0.f, 0.f, 0.f};
#pragma unroll
                        for (int kk = 0; kk < 4; ++kk) {
                            const bf16x8_t a = *(const LAS bf16x8_t*)(L + ksoff + (16 * ck + li) * SC_RS + kk * 64 + q * 16);
                            const bf16x8_t bq = *(const LAS bf16x8_t*)(L + SC_QS + (16 * cq + li) * SC_RS + kk * 64 + q * 16);
                            acc = __builtin_amdgcn_mfma_f32_16x16x32_bf16(a, bq, acc, 0, 0, 0);
                        }
                        if (cq == ck) {
#pragma unroll
                            for (int r = 0; r < 4; ++r) if (4 * q + r > li) acc[r] = 0.f;
                        }
                        *(LAS v2u*)(L + SC_A + (16 * cq + li) * SC_TS + (16 * ck + 4 * q) * 2) = (v2u){cvtpk(acc[0], acc[1]), cvtpk(acc[2], acc[3])};
                    }
                }
#pragma unroll
                for (int it = 0; it < 4; ++it) O[it] = (f32x4){0.f, 0.f, 0.f, 0.f};
#pragma unroll
                for (int kk = 0; kk < 4; ++kk) {
                    const v4u sb = (v4u){cvtpk(S[2 * kk][0], S[2 * kk][1]), cvtpk(S[2 * kk][2], S[2 * kk][3]), cvtpk(S[2 * kk + 1][0], S[2 * kk + 1][1]), cvtpk(S[2 * kk + 1][2], S[2 * kk + 1][3])};
                    const bf16x8_t bs = __builtin_bit_cast(bf16x8_t, sb);
#pragma unroll
                    for (int it = 0; it < 4; ++it) {
                        const v2u a_lo = *(const LAS v2u*)(L + SC_QB + (16 * it + li) * SC_RS + kk * 64 + q * 8), a_hi = *(const LAS v2u*)(L + SC_QB + (16 * it + li) * SC_RS + kk * 64 + 32 + q * 8);
                        const bf16x8_t a = __builtin_bit_cast(bf16x8_t, (v4u){a_lo.x, a_lo.y, a_hi.x, a_hi.y});
                        O[it] = __builtin_amdgcn_mfma_f32_16x16x32_bf16(a, bs, O[it], 0, 0, 0);
                    }
                }
                SC_LBAR();
            }
            bf16x8_t bv[2];
#pragma unroll
            for (int is = 0; is < 2; ++is) bv[is] = *(const LAS bf16x8_t*)(L + SC_VT + (16 * w + li) * SC_TS + is * 64 + q * 16);
            if (!STATE_ONLY) {
#pragma unroll
                for (int it = 0; it < 4; ++it)
#pragma unroll
                    for (int ks = 0; ks < 2; ++ks) if (ks == 0 || it >= 2) {
                        const bf16x8_t a = *(const LAS bf16x8_t*)(L + SC_A + (16 * it + li) * SC_TS + ks * 64 + q * 16);
                        O[it] = __builtin_amdgcn_mfma_f32_16x16x32_bf16(a, bv[ks], O[it], 0, 0, 0);
                    }
                GAS float* Od = (GAS float*)(F.ws + (dir ? WS_OB : WS_OF));
#pragma unroll
                for (int it = 0; it < 4; ++it)
#pragma unroll
                    for (int r = 0; r < 4; ++r) { const int i = 16 * it + 4 * q + r; const long row = orow0 + (dir ? -i : i); Od[row * 1024 + h * 128 + 16 * w + li] = O[it][r]; }
            }
#pragma unroll
            for (int kt = 0; kt < 8; ++kt) {
                const f32x4 dv = *(const LAS f32x4*)(L + SC_D + (16 * kt + 4 * q) * 4);
                S[kt] = S[kt] * dv;
#pragma unroll
                for (int is = 0; is < 2; ++is) {
                    const bf16x8_t a = *(const LAS bf16x8_t*)(L + SC_KST + (16 * kt + li) * SC_TS + is * 64 + q * 16);
                    S[kt] = __builtin_amdgcn_mfma_f32_16x16x32_bf16(a, bv[is], S[kt], 0, 0, 0);
                }
            }
        }
#undef SC_LOAD
        if (STATE_ONLY) {
            GAS float* hp = HS + ((size_t)((seq * 8 + seg) * 8 + w) * 64 + lane) * 32;
#pragma unroll
            for (int kt = 0; kt < 8; ++kt) *(GAS f32x4*)(hp + 4 * kt) = S[kt];
            if (w == 0) *(GAS f32x2_t*)(DS + (size_t)(seq * 8 + seg) * 128 + 2 * lane) = (f32x2_t){__expf(segtot0), __expf(segtot1)};
        }
        SC_LBAR();
    }
}

__device__ __forceinline__ void readout_phase(Frame& F, int e, int nrows) {
    const GAS bf16* P = (const GAS bf16*)(F.ws + WS_P); GAS bf16* Y = (GAS bf16*)(F.ws + WS_Y);
    {
        const GAS float* OF = (const GAS float*)(F.ws + WS_OF); const GAS float* OB = (const GAS float*)(F.ws + WS_OB); const GAS float* ng = in_ptr(11) + (size_t)e * 1024;
        const int gw = F.bid * NWAVES + F.wave, NGW = F.G * NWAVES;
        for (int row = gw; row < nrows; row += NGW) {
            const int col = 16 * F.lane; f32x4 o[4]; float ss = 0.f;
#pragma unroll
            for (int j = 0; j < 4; ++j) { o[j] = *(const GAS f32x4*)(OF + (size_t)row * 1024 + col + 4 * j) + *(const GAS f32x4*)(OB + (size_t)row * 1024 + col + 4 * j);
                ss += (o[j][0] * o[j][0] + o[j][1] * o[j][1]) + (o[j][2] * o[j][2] + o[j][3] * o[j][3]); }
            ss += __shfl_xor(ss, 1); ss += __shfl_xor(ss, 2); ss += __shfl_xor(ss, 4);
            const float r = rsqrtf(ss * (1.0f / 128.0f) + EPS);
            const v4u s0 = *(const GAS v4u*)(P + (size_t)row * INC + 4096 + col), s1 = *(const GAS v4u*)(P + (size_t)row * INC + 4096 + col + 8);
            const float sgv[16] = {bflo(s0.x), bfhi(s0.x), bflo(s0.y), bfhi(s0.y), bflo(s0.z), bfhi(s0.z), bflo(s0.w), bfhi(s0.w), bflo(s1.x), bfhi(s1.x), bflo(s1.y), bfhi(s1.y), bflo(s1.z), bfhi(s1.z), bflo(s1.w), bfhi(s1.w)};
            float y[16];
#pragma unroll
            for (int j = 0; j < 4; ++j) { const f32x4 g4 = *(const GAS f32x4*)(ng + col + 4 * j);
#pragma unroll
                for (int q = 0; q < 4; ++q) y[4 * j + q] = o[j][q] * r * g4[q] * sgv[4 * j + q]; }
            v4u w0, w1; w0.x = pk2(y[0], y[1]); w0.y = pk2(y[2], y[3]); w0.z = pk2(y[4], y[5]); w0.w = pk2(y[6], y[7]); w1.x = pk2(y[8], y[9]); w1.y = pk2(y[10], y[11]); w1.z = pk2(y[12], y[13]); w1.w = pk2(y[14], y[15]);
            *(GAS v4u*)(Y + (size_t)row * D + col) = w0; *(GAS v4u*)(Y + (size_t)row * D + col + 8) = w1;
        }
    }
}
__device__ __forceinline__ void spatial_mfma_phase(Frame& F, int e, int nchunks) {
    const GAS bf16* P = (const GAS bf16*)(F.ws + WS_P); GAS bf16* Y = (GAS bf16*)(F.ws + WS_Y);
    LAS unsigned char* L = F.lds; constexpr int VP = 272;
    const GAS float* gv = in_ptr(14) + (size_t)e * 1024; const GAS float* bsp = in_ptr(13) + (size_t)e * 1024;
    const GAS bf16* wsb = (const GAS bf16*)(F.ws + WS_WSB) + (size_t)e * 8 * 128 * 128;
    const int w = F.wave, lane = F.lane, q = lane >> 4, li = lane & 15;
    const int nitems = nchunks * 8;
    if (F.bid >= nitems) return;
    const bool gfix = (F.G & 7) == 0; const int g0 = F.bid & 7;
    bf16x8_t wf[4];
#pragma unroll
    for (int ks = 0; ks < 4; ++ks) wf[ks] = *(const GAS bf16x8_t*)(wsb + ((size_t)g0 * 128 + 16 * w + li) * 128 + 32 * ks + 8 * q);
    unsigned xr[16];
#define SP_LOAD(item_) do { const int n_ = (item_) >> 3, g_ = (item_) & 7; const size_t rb_ = n_ < 128 ? (size_t)n_ * 128 : (size_t)NLAT + (size_t)(n_ - 128) * 128; \
        _Pragma("unroll") for (int i = 0; i < 16; ++i) xr[i] = *(const GAS unsigned*)(P + (rb_ + 16 * w + i) * INC + 6144 + g_ * 128 + 2 * lane); } while (0)
    SP_LOAD(F.bid);
    for (int item = F.bid; item < nitems; item += F.G) {
        const int n = item >> 3, g = item & 7; const size_t rowbase = n < 128 ? (size_t)n * 128 : (size_t)NLAT + (size_t)(n - 128) * 128;
        const float gva = gv[g * 128 + 2 * lane], gvb = gv[g * 128 + 2 * lane + 1];
        float s1[16], s2[16], x0[16], x1[16];
#pragma unroll
        for (int i = 0; i < 16; ++i) { x0[i] = bflo(xr[i]); x1[i] = bfhi(xr[i]); s1[i] = x0[i] + x1[i]; s2[i] = x0[i] * x0[i] + x1[i] * x1[i]; }
#pragma unroll
        for (int o = 1; o < 64; o <<= 1)
#pragma unroll
            for (int i = 0; i < 16; ++i) { s1[i] += __shfl_xor(s1[i], o); s2[i] += __shfl_xor(s2[i], o); }
#pragma unroll
        for (int i = 0; i < 16; i += 2) {
            const int s = 16 * w + i;
            const float ma = s1[i] * (1.0f / 128.0f), mb = s1[i + 1] * (1.0f / 128.0f);
            const float ra = rsqrtf(fmaxf(s2[i] * (1.0f / 128.0f) - ma * ma, 0.f) + EPS), rb = rsqrtf(fmaxf(s2[i + 1] * (1.0f / 128.0f) - mb * mb, 0.f) + EPS);
            *(LAS unsigned*)(L + (2 * lane) * VP + 2 * s) = cvtpk((x0[i] - ma) * ra * gva, (x0[i + 1] - mb) * rb * gva);
            *(LAS unsigned*)(L + (2 * lane + 1) * VP + 2 * s) = cvtpk((x1[i] - ma) * ra * gvb, (x1[i + 1] - mb) * rb * gvb);
        }
        if (item + F.G < nitems) SP_LOAD(item + F.G);
        __syncthreads();
        f32x4 acc[8];
#pragma unroll
        for (int ct = 0; ct < 8; ++ct) acc[ct] = (f32x4){0.f, 0.f, 0.f, 0.f};
#pragma unroll
        for (int ks = 0; ks < 4; ++ks) {
            const bf16x8_t wfk = gfix ? wf[ks] : *(const GAS bf16x8_t*)(wsb + ((size_t)g * 128 + 16 * w + li) * 128 + 32 * ks + 8 * q);
#pragma unroll
            for (int ct = 0; ct < 8; ++ct) {
                const bf16x8_t vf = *(const LAS bf16x8_t*)(L + (16 * ct + li) * VP + 64 * ks + 16 * q);
                acc[ct] = __builtin_amdgcn_mfma_f32_16x16x32_bf16(vf, wfk, acc[ct], 0, 0, 0);
            }
        }
        const int t = 16 * w + li; const float bias = bsp[g * 128 + t]; const size_t row = rowbase + t;
        v2u uw[8];
#pragma unroll
        for (int ct = 0; ct < 8; ++ct) uw[ct] = *(const GAS v2u*)(P + row * INC + 5120 + g * 128 + 16 * ct + 4 * q);
#pragma unroll
        for (int ct = 0; ct < 8; ++ct) {
            const int c = 16 * ct + 4 * q;
            *(GAS v2u*)(Y + row * D + 1024 + g * 128 + c) = (v2u){cvtpk(bflo(uw[ct].x) * (acc[ct][0] + bias), bfhi(uw[ct].x) * (acc[ct][1] + bias)), cvtpk(bflo(uw[ct].y) * (acc[ct][2] + bias), bfhi(uw[ct].y) * (acc[ct][3] + bias))};
        }
        __syncthreads();
    }
#undef SP_LOAD
}

__device__ __forceinline__ void pool_fast_phase(Frame& F, bool with_ctx) {
    const GAS bf16* PP = (const GAS bf16*)(F.ws + WS_P); GAS bf16* Y = (GAS bf16*)(F.ws + WS_Y);
    LAS float* vs = (LAS float*)F.lds;
    for (int br0 = F.bid; br0 < 256; br0 += F.G) {
        const int br = (F.G == 256) ? ((br0 & 7) * 32 + (br0 >> 3)) : br0;
        const int b = br >> 7, r = br & 127;
#pragma unroll 1
        for (int cblk = 0; cblk < 8; ++cblk) {
            const int g = cblk >> 1, k = 2 << g, half = k >> 1;
            const int rlo = max(r - half, 0), rhi = min(r - half + k, 128);
            unsigned lofs[4]; float s[4][8];
#pragma unroll
            for (int j = 0; j < 4; ++j) { const int idx = F.tid + 512 * j; lofs[j] = (unsigned)((b * SEQ + (idx >> 5)) * D + cblk * 256 + (idx & 31) * 8);
#pragma unroll
                for (int u = 0; u < 8; ++u) s[j][u] = 0.f; }
#pragma unroll 4
            for (int rr = rlo; rr < rhi; ++rr) {
                const unsigned ro = (unsigned)rr * (unsigned)(64 * D);
#pragma unroll
                for (int j = 0; j < 4; ++j) { const v4u x = *(const GAS v4u*)(PP + (lofs[j] + ro));
                    s[j][0] += bflo(x.x); s[j][1] += bfhi(x.x); s[j][2] += bflo(x.y); s[j][3] += bfhi(x.y); s[j][4] += bflo(x.z); s[j][5] += bfhi(x.z); s[j][6] += bflo(x.w); s[j][7] += bfhi(x.w); }
            }
#pragma unroll
            for (int j = 0; j < 4; ++j) { const int idx = F.tid + 512 * j, c = idx >> 5, vec = idx & 31;
                *(LAS f32x4*)(vs + c * 256 + vec * 8) = (f32x4){s[j][0], s[j][1], s[j][2], s[j][3]}; *(LAS f32x4*)(vs + c * 256 + vec * 8 + 4) = (f32x4){s[j][4], s[j][5], s[j][6], s[j][7]}; }
            __syncthreads();
            v4u sf[4];
#pragma unroll
            for (int j = 0; j < 4; ++j) sf[j] = *(const GAS v4u*)(PP + (lofs[j] + (unsigned)r * (unsigned)(64 * D)));
#pragma unroll
            for (int j = 0; j < 4; ++j) {
                const int idx = F.tid + 512 * j, c = idx >> 5, vec = idx & 31;
                const int clo = max(c - half, 0), chi = min(c - half + k, 64);
                f32x4 s0 = {0.f, 0.f, 0.f, 0.f}, s1 = s0;
#pragma unroll 4
                for (int cc = clo; cc < chi; ++cc) { s0 += *(const LAS f32x4*)(vs + cc * 256 + vec * 8); s1 += *(const LAS f32x4*)(vs + cc * 256 + vec * 8 + 4); }
                const float inv = 1.0f / (float)((rhi - rlo) * (chi - clo));
                v4u o; o.x = pk2(s0[0] * inv - bflo(sf[j].x), s0[1] * inv - bfhi(sf[j].x)); o.y = pk2(s0[2] * inv - bflo(sf[j].y), s0[3] * inv - bfhi(sf[j].y));
                o.z = pk2(s1[0] * inv - bflo(sf[j].z), s1[1] * inv - bfhi(sf[j].z)); o.w = pk2(s1[2] * inv - bflo(sf[j].w), s1[3] * inv - bfhi(sf[j].w));
                *(GAS v4u*)(Y + (lofs[j] + (unsigned)r * (unsigned)(64 * D))) = o;
            }
            __syncthreads();
        }
    }
    if (with_ctx) {
        const size_t total = (size_t)NCTX * 256, nthr = (size_t)F.G * NWAVES * 64;
        for (size_t idx = (size_t)F.bid * NWAVES * 64 + F.tid; idx < total; idx += nthr) {
            const int rowc = (int)(idx >> 8), col = (int)(idx & 255) * 8, g = col >> 9, k = 2 << g, half = k >> 1;
            const int b = rowc >> 8, t = rowc & 255, lo = max(t - half, 0), hi = min(t - half + k, CTXL);
            float sum[8];
#pragma unroll
            for (int j = 0; j < 8; ++j) sum[j] = 0.f;
            for (int tt = lo; tt < hi; ++tt) {
                const v4u w = *(const GAS v4u*)(PP + ((size_t)NLAT + b * CTXL + tt) * D + col);
                sum[0] += bflo(w.x); sum[1] += bfhi(w.x); sum[2] += bflo(w.y); sum[3] += bfhi(w.y); sum[4] += bflo(w.z); sum[5] += bfhi(w.z); sum[6] += bflo(w.w); sum[7] += bfhi(w.w);
            }
            const float inv = 1.0f / (float)(hi - lo);
            const size_t off = ((size_t)NLAT + rowc) * D + col;
            const v4u s = *(const GAS v4u*)(PP + off);
            v4u o; o.x = pk2(sum[0] * inv - bflo(s.x), sum[1] * inv - bfhi(s.x)); o.y = pk2(sum[2] * inv - bflo(s.y), sum[3] * inv - bfhi(s.y));
            o.z = pk2(sum[4] * inv - bflo(s.z), sum[5] * inv - bfhi(s.z)); o.w = pk2(sum[6] * inv - bflo(s.w), sum[7] * inv - bfhi(s.w));
            *(GAS v4u*)(Y + off) = o;
        }
    }
}

constexpr unsigned CODE_WARM_BYTES = 200 * 1024;
constexpr int N_PHASES = 31;
__global__ void __launch_bounds__(NWAVES * 64, 2) fwd(Args args) {
    extern __shared__ __attribute__((aligned(16))) unsigned char lds[];
    Frame F;
    F.lds = (LAS unsigned char*)lds;
    F.tid = threadIdx.x; F.lane = F.tid & 63; F.wave = __builtin_amdgcn_readfirstlane(F.tid >> 6);
    F.G = gridDim.x; F.bid = blockIdx.x;
    F.out = (GAS float*)args.out; F.ws = (GAS unsigned char*)args.ws;
    {
        unsigned long long pc_; asm volatile("s_getpc_b64 %0" : "=s"(pc_));
        const unsigned off_ = (unsigned)(((F.bid >> 3) * NWAVES + F.wave) * 1024 + F.lane * 16);
        if (off_ < CODE_WARM_BYTES) { const v4u c_ = *(const GAS v4u*)((pc_ & ~255ull) + off_); asm volatile("" :: "v"(c_)); }
    }
    for (int u = F.tid; u < (LDS_BYTES - LDSCTL_OFF) / 4; u += NWAVES * 64) ((LAS unsigned*)(F.lds + LDSCTL_OFF))[u] = 0u;
    __syncthreads();
    volatile LAS unsigned* MISC = (volatile LAS unsigned*)(F.lds + MISC_OFF);
    XcdBarrier bar; bar.bar = (unsigned*)(args.ws + WS_CTL) + CW_BAR; bar.x = 0; bar.st = nullptr;
    if (!MK_PER_PHASE) bar = xcd_barrier_post((unsigned*)(args.ws + WS_CTL) + CW_BAR, MISC + 8);
    const int lo = args.ph_lo, hi = args.ph_hi;
#ifndef SITE_MASK
#define SITE_MASK 0xFFFF
#endif
#define SITE(i) ((SITE_MASK >> (i)) & 1)
#define IN(k) (lo <= (k) && (k) < hi)
#define SEAM(k, kn) do { if (!MK_PER_PHASE && IN(k) && IN(kn)) xcd_barrier(bar); } while (0)
#define WSP(T, off) ((GAS T*)(F.ws + (off)))
#define MODS_L(L) ((const GAS float*)(F.ws + WS_MODS) + (size_t)(L) * 3 * NMOD)

    if (SITE(0) && IN(0)) { FRESH(F); prologue_phase(F); }
    SEAM(0, 1);
    if (SITE(1) && IN(1)) { FRESH(F); prep_phase(F); }
    SEAM(1, 2);
#define RS_(i) (WSP(unsigned long long, WS_RS) + (size_t)(i) * MR)
#define GS_(L, j) (WSP(const float, WS_GS) + (size_t)((L) * 2 + (j)) * 3 * D)
#define CB_(L, j) (WSP(const float, WS_CB) + (size_t)(L) * 3 * 16384 + ((j) ? 8192 : 0))
    for (int L = 0; L < 4; ++L) {
        const int pb = 2 + 7 * L, e = L >> 1;
        const bool cfull = L < 2;
        if ((L & 1) == 0) {
            if (SITE(2) && IN(pb + 0)) {
                FRESH(F);
                pg8::Gemm g{WSP(bf16, WS_H), WSP(const bf16, WS_WIN) + (size_t)e * INC * D, D, D, D, 0}; pg8::StaticOrder S; S.init((cfull ? MR : NLAT) / 256, INC / 256, F.G, F.bid);
                pg8::EpiIn E{WSP(bf16, WS_P), WSP(float, WS_G), WSP(const float, WS_LB) + (size_t)e * 2048, WSP(bf16, WS_QH), WSP(bf16, WS_KH), WSP(bf16, WS_VH), RS_(2 * L), CB_(L, 0)};
                pg8::gemm_phase<pg8::EpiIn, true>(F.lds, g, S, E);
                FRESH(F);
                cg::CEpiIn CE{WSP(bf16, WS_P), WSP(float, WS_G), WSP(const float, WS_LB) + (size_t)e * 2048, WSP(bf16, WS_QH), WSP(bf16, WS_KH), WSP(bf16, WS_VH), RS_(2 * L), CB_(L, 0) + 2 * 16384};
                if (!cfull) cg::ctx_gemm<cg::CEpiIn>(F.lds, F.bid, F.G, WSP(const bf16, WS_H) + (size_t)NLAT * D, D, WSP(const bf16, WS_WIN) + (size_t)e * INC * D, D, 1024, 4096, D, 0, NLAT, CE);
            }
            SEAM(pb + 0, pb + 1);
            if (SITE(3) && IN(pb + 1)) {
                if ((F.bid >> 3) & 1) { FRESH(F); spatial_mfma_phase(F, e, cfull ? 132 : 128); FRESH(F); scan_fast_phase<true>(F); }
                else { FRESH(F); scan_fast_phase<true>(F); FRESH(F); spatial_mfma_phase(F, e, cfull ? 132 : 128); }
            }
            SEAM(pb + 1, pb + 2);
            if (SITE(13) && IN(pb + 2)) { FRESH(F); scan_fast_phase<false>(F); }
            SEAM(pb + 2, pb + 3);
            if (SITE(4) && IN(pb + 3)) { FRESH(F); readout_phase(F, e, cfull ? MR : NLAT); }
            SEAM(pb + 3, pb + 4);
            if (SITE(5) && IN(pb + 4)) {
                FRESH(F);
                pg8::Gemm g{WSP(bf16, WS_Y), WSP(const bf16, WS_WOUT) + (size_t)e * D * D, D, D, D, 0}; pg8::StaticOrder S; S.init(NLAT / 256, D / 256, F.G, F.bid);
                pg8::EpiRes E{WSP(bf16, WS_X), in_ptr(0), L == 0, MODS_L(L) + 4096, NMOD, nullptr, nullptr, WSP(bf16, WS_H), GS_(L, 1), RS_(2 * L + 1), nullptr};
                pg8::gemm_phase<pg8::EpiRes, true>(F.lds, g, S, E);
                if (cfull) {
                    FRESH(F);
                    cg::CEpiRes CE{WSP(bf16, WS_X), in_ptr(2) - (size_t)NLAT * D, L == 0, MODS_L(L) + 2 * NMOD + 4096, nullptr, nullptr, WSP(bf16, WS_H), GS_(L, 1) + 2 * D, RS_(2 * L + 1)};
                    cg::ctx_gemm<cg::CEpiRes>(F.lds, F.bid, F.G, WSP(const bf16, WS_Y) + (size_t)NLAT * D, D, WSP(const bf16, WS_WOUT) + (size_t)e * D * D, D, 0, D, D, 0, NLAT, CE);
                }
            }
        } else {
            if (SITE(6) && IN(pb + 0)) {
                FRESH(F);
                pg8::Gemm g{WSP(bf16, WS_H), WSP(const bf16, WS_WP) + (size_t)e * D * D, D, D, D, 0}; pg8::StaticOrder S; S.init(NLAT / 256, D / 256, F.G, F.bid);
                pg8::EpiAct<0> E{WSP(bf16, WS_P), D, RS_(2 * L), CB_(L, 0)};
                pg8::gemm_phase<pg8::EpiAct<0>, true>(F.lds, g, S, E);
                if (cfull) {
                    FRESH(F);
                    cg::CEpiAct<0> CE{WSP(bf16, WS_P), D, RS_(2 * L), CB_(L, 0) + 2 * 16384};
                    cg::ctx_gemm<cg::CEpiAct<0>>(F.lds, F.bid, F.G, WSP(const bf16, WS_H) + (size_t)NLAT * D, D, WSP(const bf16, WS_WP) + (size_t)e * D * D, D, 0, D, D, 0, NLAT, CE);
                }
            }
            SEAM(pb + 0, pb + 1);
            if (SITE(7) && IN(pb + 1)) { FRESH(F); pool_fast_phase(F, cfull); }
            SEAM(pb + 1, pb + 4);
            if (SITE(8) && IN(pb + 4)) {
                FRESH(F);
                pg8::Gemm g{WSP(bf16, WS_Y), WSP(const bf16, WS_WG) + (size_t)e * D * 512, D, 512, 512, 512}; pg8::StaticOrder S; S.init(NLAT / 256, D / 256, F.G, F.bid);
                pg8::EpiRes E{WSP(bf16, WS_X), nullptr, false, MODS_L(L) + 4096, NMOD, in_ptr(17) + (size_t)e * D, in_ptr(18) + (size_t)e * D, WSP(bf16, WS_H), GS_(L, 1), RS_(2 * L + 1), nullptr};
                pg8::gemm_phase<pg8::EpiRes, true>(F.lds, g, S, E);
                if (cfull) {
                    FRESH(F);
                    cg::CEpiRes CE{WSP(bf16, WS_X), nullptr, false, MODS_L(L) + 2 * NMOD + 4096, in_ptr(17) + (size_t)e * D, in_ptr(18) + (size_t)e * D, WSP(bf16, WS_H), GS_(L, 1) + 2 * D, RS_(2 * L + 1)};
                    cg::ctx_gemm<cg::CEpiRes>(F.lds, F.bid, F.G, WSP(const bf16, WS_Y) + (size_t)NLAT * D, D, WSP(const bf16, WS_WG) + (size_t)e * D * 512, 512, 0, D, 512, 512, NLAT, CE);
                }
            }
        }
        SEAM(pb + 4, pb + 5);
        if (SITE(10) && IN(pb + 5)) {
            FRESH(F);
            pg8::Gemm g{WSP(bf16, WS_H), WSP(const bf16, WS_WUP) + (size_t)L * DFF * D, D, D, D, 0}; pg8::StaticOrder S; S.init((cfull ? MR : NLAT) / 256, DFF / 256, F.G, F.bid);
            pg8::EpiAct<1> E{WSP(bf16, WS_HID), DFF, RS_(2 * L + 1), CB_(L, 1)};
            pg8::gemm_phase<pg8::EpiAct<1>, true>(F.lds, g, S, E);
        }
        SEAM(pb + 5, pb + 6);
        if (SITE(11) && IN(pb + 6)) {
            FRESH(F);
            pg8::Gemm g{WSP(bf16, WS_HID), WSP(const bf16, WS_WDN) + (size_t)L * D * DFF, DFF, DFF, DFF, 0}; pg8::StaticOrder S; S.init(NLAT / 256, D / 256, F.G, F.bid);
            pg8::EpiRes E{WSP(bf16, WS_X), nullptr, false, MODS_L(L) + 10240, NMOD, nullptr, nullptr, L < 3 ? WSP(bf16, WS_H) : (GAS bf16*)nullptr, GS_(L + 1, 0), RS_(2 * L + 2), L == 3 ? F.out : (GAS float*)nullptr};
            pg8::gemm_phase<pg8::EpiRes, true>(F.lds, g, S, E);
            if (cfull) {
                FRESH(F);
                cg::CEpiRes CE{WSP(bf16, WS_X), nullptr, false, MODS_L(L) + 2 * NMOD + 10240, nullptr, nullptr, WSP(bf16, WS_H), GS_(L + 1, 0) + 2 * D, RS_(2 * L + 2)};
                cg::ctx_gemm<cg::CEpiRes>(F.lds, F.bid, F.G, WSP(const bf16, WS_HID) + (size_t)NLAT * DFF, DFF, WSP(const bf16, WS_WDN) + (size_t)L * D * DFF, DFF, 0, D, DFF, 0, NLAT, CE);
            }
        }
        SEAM(pb + 6, pb + 7);
    }
    if (SITE(12) && IN(30)) { FRESH(F); final_norm_phase(F); }
#undef IN
#undef SEAM
}

extern "C" void kernel_launch(void* const* d_in, const int* in_sizes, int n_in, void* d_out, int out_size, void* d_ws, size_t ws_size, hipStream_t stream) {
    static int grid = 0;
    if (grid == 0) {
        if (n_in != 22 || in_sizes[0] != NLAT * D || out_size != NLAT * D || ws_size < WS_END) {
            fprintf(stderr, "kernel_launch: unexpected shapes (n_in %d, in0 %d, out %d, ws %zu, need %zu); nothing launched\n", n_in, n_in > 0 ? in_sizes[0] : -1, out_size, ws_size, (size_t)WS_END); grid = -1; return; }
        int dev = 0, cus = 0, per_cu = 0;
        if (hipGetDevice(&dev) != hipSuccess || hipDeviceGetAttribute(&cus, hipDeviceAttributeMultiprocessorCount, dev) != hipSuccess) { fprintf(stderr, "kernel_launch: device query failed\n"); grid = -1; return; }
        if (hipFuncSetAttribute((const void*)fwd, hipFuncAttributeMaxDynamicSharedMemorySize, LDS_BYTES) != hipSuccess) { fprintf(stderr, "kernel_launch: hipFuncSetAttribute failed\n"); grid = -1; return; }
        if (hipOccupancyMaxActiveBlocksPerMultiprocessor(&per_cu, (const void*)fwd, NWAVES * 64, LDS_BYTES) != hipSuccess || per_cu < 1)
            fprintf(stderr, "kernel_launch: note: occupancy query reports %d workgroups per CU\n", per_cu);
        (void)hipGetLastError();
        grid = cus;
    }
    if (grid < 0) return;
    if (hipMemsetAsync((char*)d_ws + WS_CTL, 0, CTL_ZERO_BYTES, stream) != hipSuccess) { fprintf(stderr, "kernel_launch: memset failed\n"); return; }
    Args a{};
    for (int i = 0; i < 22; ++i) a.in[i] = (const float*)d_in[i];
    a.out = (float*)d_out; a.ws = (unsigned char*)d_ws;
#if MK_PER_PHASE
    for (int ph = 0; ph < N_PHASES; ++ph) {
        if (ph >= 2 && ph <= 29) { const int L = (ph - 2) / 7, s = (ph - 2) % 7; if ((L & 1) && (s == 2 || s == 3)) continue; }
        a.ph_lo = ph; a.ph_hi = ph + 1;
        hipLaunchKernelGGL(fwd, dim3(grid), dim3(NWAVES * 64), LDS_BYTES, stream, a);
    }
#else
    a.ph_lo = 0; a.ph_hi = N_PHASES;
    hipLaunchKernelGGL(fwd, dim3(grid), dim3(NWAVES * 64), LDS_BYTES, stream, a);
#endif
    const hipError_t le = hipPeekAtLastError();
    if (le != hipSuccess) fprintf(stderr, "kernel_launch: launch failed: %s\n", hipGetErrorName(le));
}
```

```cpp
#include <hip/hip_runtime.h>
#include <cstdio>
#include <cstdint>

#ifndef WGM_IN
#define WGM_IN 4
#endif
#ifndef WGM_OUT
#define WGM_OUT 4
#endif
#ifndef WGM_PIN
#define WGM_PIN 4
#endif
#ifndef WGM_GRP
#define WGM_GRP 4
#endif
#ifndef WGM_UP
#define WGM_UP 4
#endif
#ifndef WGM_DN
#define WGM_DN 4
#endif
#ifndef MK_PER_PHASE
#define MK_PER_PHASE 0
#endif

namespace pg8 {
#define PG8_LAS __attribute__((address_space(3)))
#define GAS __attribute__((address_space(1)))
typedef unsigned short bf16_t;
typedef short bf16x8 __attribute__((ext_vector_type(8)));
typedef float f32x4 __attribute__((ext_vector_type(4)));
typedef float f32x2 __attribute__((ext_vector_type(2)));
typedef unsigned u32x4 __attribute__((ext_vector_type(4)));
typedef unsigned u32x2 __attribute__((ext_vector_type(2)));
constexpr int BM = 256, BK = 64, HALF = 128, HTB = HALF * BK * 2, STAGE_BYTES = 8 * HTB, NXCD = 8;

__host__ __device__ __forceinline__ int lds_byte(int r, int c) { const int st = (r >> 4) * 2 + (c >> 5), rr = r & 15, cc = c & 31, ob = rr * 64 + cc * 2; return st * 1024 + (ob ^ (((ob >> 9) & 1) << 5)); }
__host__ __device__ __forceinline__ void stage_rc(int b, int& R, int& C) { const int st = b / 1024, sb = b % 1024, swz = sb ^ (((sb >> 9) & 1) << 5); R = (st >> 1) * 16 + swz / 64; C = (st & 1) * 32 + (swz % 64) / 2; }
__host__ __device__ __forceinline__ int perm32(int rho) { const int n = rho >> 4, i = rho & 15; return 8 * (i >> 2) + 4 * n + (i & 3); }

struct Unit { int pm, pn; };
struct Gemm { const GAS bf16_t* A; const GAS bf16_t* Bt; int lda, ldb, K, agrp; };

struct StaticOrder {
    int nM, nN, nwg, G, c, WGM;
    __host__ __device__ void init(int nM_, int nN_, int G_, int c_, int wgm_) { nM = nM_; nN = nN_; nwg = nM * nN; G = G_; c = c_; WGM = wgm_; }
    __host__ __device__ bool next(int i, Unit& u) const {
        const long L = (long)i * G + c; if (L >= nwg) return false;
        int wgid = (int)L; { const int q = nwg / NXCD, r = nwg % NXCD, xcd = wgid % NXCD, off = wgid / NXCD; wgid = (xcd < r ? xcd * (q + 1) : r * (q + 1) + (xcd - r) * q) + off; }
        const int nig = WGM * nN, gid = wgid / nig, fm = gid * WGM, gsz = (nM - fm) < WGM ? (nM - fm) : WGM;
        u.pm = fm + ((wgid % nig) % gsz); u.pn = (wgid % nig) / gsz; return true;
    }
};

__device__ __forceinline__ unsigned cvt_pk_bf16(float lo, float hi) { unsigned r; asm volatile("v_cvt_pk_bf16_f32 %0, %1, %2" : "=v"(r) : "v"(lo), "v"(hi)); return r; }
__device__ __forceinline__ f32x2 gelu_pk(f32x2 v) {
    const f32x2 av = __builtin_elementwise_abs(v), d = av * 0.2316418882f + 1.0f;
    f32x2 t; t.x = __builtin_amdgcn_rcpf(d.x); t.y = __builtin_amdgcn_rcpf(d.y);
    f32x2 q = t * 0.5307027145f + (-0.7265760135f); q = q * t + 0.7107068705f; q = q * t + (-0.142248368f); q = q * t + 0.127414796f; q = q * t;
    const f32x2 s = (v * v) * (-0.72134752044f);
    f32x2 e; e.x = __builtin_amdgcn_exp2f(s.x); e.y = __builtin_amdgcn_exp2f(s.y);
    const f32x2 m = v * (q * e), r = v - m;
    f32x2 o; o.x = v.x < 0.f ? m.x : r.x; o.y = v.y < 0.f ? m.y : r.y; return o;
}
__device__ __forceinline__ f32x4 gelu4(f32x4 v) { const f32x2 a = gelu_pk((f32x2){v[0], v[1]}), b = gelu_pk((f32x2){v[2], v[3]}); return (f32x4){a.x, a.y, b.x, b.y}; }
__device__ __forceinline__ float sigmoidf_(float x) { return __builtin_amdgcn_rcpf(1.0f + __expf(-x)); }

__device__ __forceinline__ size_t hm_off(int r, int h) { return r < 16384 ? ((size_t)(((r >> 13) * 8 + h) * 8192 + (r & 8191))) * 128 : (size_t)16 * 8192 * 128 + ((size_t)((((r - 16384) >> 8) * 8 + h) * 256 + ((r - 16384) & 255))) * 128; }
constexpr size_t HM_ELEMS = (size_t)16 * (8192 + 256) * 128;
struct EpiIn {
    static constexpr bool PERM = true;
    GAS bf16_t* P; GAS float* Gl; const GAS float* lb;
    GAS bf16_t* QH; GAS bf16_t* KH; GAS bf16_t* VH;
    const GAS unsigned long long* rs; const GAS float* cb;
    __device__ __forceinline__ void operator()(const f32x4 (&acc)[2][2][4][2], const Unit& u, int wr, int wc, int fr, int fq) const {
        const int seg = u.pn >> 2;
        const int row0 = u.pm * BM + wr * 64 + fr, col0 = u.pn * BM + wc * 32 + 8 * fq;
        const GAS float* cbr = cb + (size_t)(u.pm < 32 ? 0 : (u.pm < 64 ? 1 : 2)) * 16384;
        if (seg == 1 || seg == 2) {
#pragma unroll
            for (int bj = 0; bj < 2; ++bj) {
                const int c = col0 + bj * HALF;
                const f32x4 l0 = *(const GAS f32x4*)(lb + c - 1024), l1 = *(const GAS f32x4*)(lb + c - 1024 + 4);
                const f32x4 c0 = *(const GAS f32x4*)(cbr + c), c1 = *(const GAS f32x4*)(cbr + c + 4);
#pragma unroll
                for (int ai = 0; ai < 2; ++ai)
#pragma unroll
                    for (int m = 0; m < 4; ++m) {
                        const size_t row = (size_t)(row0 + ai * HALF + m * 16);
                        const float rstd = rsqrtf((float)rs[row] * (1.0f / (2048.0f * 1048576.0f)) + 1e-6f);
                        f32x4 g0, g1;
#pragma unroll
                        for (int j = 0; j < 4; ++j) {
                            { const float f = fminf(fmaxf(acc[ai][bj][m][0][j] * rstd + c0[j], -60.f), 60.f), e = __expf(-f), sg = __builtin_amdgcn_rcpf(1.0f + e), l = l0[j];
                              g0[j] = __logf(fmaxf(l + (1.0f - l) * sg, 1e-30f)); }
                            { const float f = fminf(fmaxf(acc[ai][bj][m][1][j] * rstd + c1[j], -60.f), 60.f), e = __expf(-f), sg = __builtin_amdgcn_rcpf(1.0f + e), l = l1[j];
                              g1[j] = __logf(fmaxf(l + (1.0f - l) * sg, 1e-30f)); }
                        }
                        const size_t ho = (size_t)(seg - 1) * HM_ELEMS + hm_off((int)row, (c >> 7) & 7) + (c & 127);
                        *(GAS f32x4*)(Gl + ho) = g0; *(GAS f32x4*)(Gl + ho + 4) = g1;
                    }
            }
        } else {
            const int mode = (seg == 4) ? 1 : (seg >= 5 ? 2 : 0);
#pragma unroll
            for (int ai = 0; ai < 2; ++ai)
#pragma unroll
                for (int m = 0; m < 4; ++m) {
                    const size_t row = (size_t)(row0 + ai * HALF + m * 16);
                    const float rstd = rsqrtf((float)rs[row] * (1.0f / (2048.0f * 1048576.0f)) + 1e-6f);
#pragma unroll
                    for (int bj = 0; bj < 2; ++bj) {
                        f32x4 v0 = acc[ai][bj][m][0] * rstd + *(const GAS f32x4*)(cbr + col0 + bj * HALF), v1 = acc[ai][bj][m][1] * rstd + *(const GAS f32x4*)(cbr + col0 + bj * HALF + 4);
                        if (mode == 1) {
#pragma unroll
                            for (int j = 0; j < 4; ++j) { v0[j] = v0[j] * sigmoidf_(v0[j]); v1[j] = v1[j] * sigmoidf_(v1[j]); }
                        } else if (mode == 2) { v0 = gelu4(v0); v1 = gelu4(v1); }
                        u32x4 w; w.x = cvt_pk_bf16(v0[0], v0[1]); w.y = cvt_pk_bf16(v0[2], v0[3]); w.z = cvt_pk_bf16(v1[0], v1[1]); w.w = cvt_pk_bf16(v1[2], v1[3]);
                        const int c = col0 + bj * HALF;
                        if (seg == 0 || seg == 3) *(GAS u32x4*)((seg == 0 ? QH : VH) + hm_off((int)row, (c >> 7) & 7) + (c & 127)) = w;
                        else *(GAS u32x4*)(P + row * 7168 + c) = w;
                    }
                }
        }
    }
};
template <int ACT> struct EpiAct {
    static constexpr bool PERM = true;
    GAS bf16_t* O; int ldc; const GAS unsigned long long* rs; const GAS float* cb;
    __device__ __forceinline__ void operator()(const f32x4 (&acc)[2][2][4][2], const Unit& u, int wr, int wc, int fr, int fq) const {
        const int row0 = u.pm * BM + wr * 64 + fr, col0 = u.pn * BM + wc * 32 + 8 * fq;
        const GAS float* cbr = cb + (size_t)(u.pm < 32 ? 0 : (u.pm < 64 ? 1 : 2)) * 16384 + col0;
        const f32x4 cb00 = *(const GAS f32x4*)(cbr), cb01 = *(const GAS f32x4*)(cbr + 4), cb10 = *(const GAS f32x4*)(cbr + HALF), cb11 = *(const GAS f32x4*)(cbr + HALF + 4);
#pragma unroll
        for (int ai = 0; ai < 2; ++ai)
#pragma unroll
            for (int m = 0; m < 4; ++m) {
                GAS bf16_t* rowp = O + (size_t)(row0 + ai * HALF + m * 16) * ldc + col0;
                const float rstd = rsqrtf((float)rs[row0 + ai * HALF + m * 16] * (1.0f / (2048.0f * 1048576.0f)) + 1e-6f);
#pragma unroll
                for (int bj = 0; bj < 2; ++bj) {
                    f32x4 v0 = acc[ai][bj][m][0] * rstd + (bj ? cb10 : cb00), v1 = acc[ai][bj][m][1] * rstd + (bj ? cb11 : cb01);
                    if (ACT == 1) {
#pragma unroll
                        for (int j = 0; j < 4; ++j) { const float a = fmaxf(v0[j], 0.f), b = fmaxf(v1[j], 0.f); v0[j] = a * a; v1[j] = b * b; }
                    }
                    u32x4 w; w.x = cvt_pk_bf16(v0[0], v0[1]); w.y = cvt_pk_bf16(v0[2], v0[3]); w.z = cvt_pk_bf16(v1[0], v1[1]); w.w = cvt_pk_bf16(v1[2], v1[3]);
                    *(GAS u32x4*)(rowp + bj * HALF) = w;
                }
            }
    }
};
__device__ __forceinline__ f32x4 bf4lo(u32x4 w) { return (f32x4){__builtin_bit_cast(float, w.x << 16), __builtin_bit_cast(float, w.x & 0xffff0000u), __builtin_bit_cast(float, w.y << 16), __builtin_bit_cast(float, w.y & 0xffff0000u)}; }
__device__ __forceinline__ f32x4 bf4hi(u32x4 w) { return (f32x4){__builtin_bit_cast(float, w.z << 16), __builtin_bit_cast(float, w.z & 0xffff0000u), __builtin_bit_cast(float, w.w << 16), __builtin_bit_cast(float, w.w & 0xffff0000u)}; }
struct EpiRes {
    static constexpr bool PERM = true;
    GAS bf16_t* X; const GAS float* Xin; bool xf32;
    const GAS float* gate; int gstride; const GAS float* bias; const GAS float* scale;
    GAS bf16_t* Hn; const GAS float* gsn; GAS unsigned long long* rsn;
    GAS float* Xout32;
    __device__ __forceinline__ void operator()(const f32x4 (&acc)[2][2][4][2], const Unit& u, int wr, int wc, int fr, int fq) const {
        const int mr = u.pm < 32 ? 0 : (u.pm < 64 ? 1 : 2);
        const GAS float* gt = gate + (size_t)mr * gstride;
        const int row0 = u.pm * BM + wr * 64 + fr, col0 = u.pn * BM + wc * 32 + 8 * fq;
        f32x4 ga[2][2], gs[2][2];
#pragma unroll
        for (int bj = 0; bj < 2; ++bj)
#pragma unroll
            for (int n = 0; n < 2; ++n) {
                const int c = col0 + bj * HALF + 4 * n;
                gs[bj][n] = Hn ? *(const GAS f32x4*)(gsn + (size_t)mr * 2048 + c) : (f32x4){0.f, 0.f, 0.f, 0.f};
                ga[bj][n] = *(const GAS f32x4*)(gt + c);
                if (scale) ga[bj][n] = ga[bj][n] * *(const GAS f32x4*)(scale + c);
            }
#pragma unroll
        for (int ai = 0; ai < 2; ++ai)
#pragma unroll
        for (int mp = 0; mp < 4; mp += 2) {
            u32x4 raw[2][2][2];
#pragma unroll
            for (int m2 = 0; m2 < 2; ++m2)
#pragma unroll
                for (int bj = 0; bj < 2; ++bj) {
                    const size_t o = (size_t)(row0 + ai * HALF + (mp + m2) * 16) * 2048 + col0 + bj * HALF;
                    if (xf32) { raw[m2][bj][0] = *(const GAS u32x4*)(Xin + o); raw[m2][bj][1] = *(const GAS u32x4*)(Xin + o + 4); }
                    else { raw[m2][bj][0] = *(const GAS u32x4*)(X + o); raw[m2][bj][1] = raw[m2][bj][0]; }
                }
            asm volatile("" ::: "memory");
#pragma unroll
            for (int m2 = 0; m2 < 2; ++m2) {
                const int m = mp + m2;
                const size_t row = (size_t)(row0 + ai * HALF + m * 16);
                float ss = 0.f;
#pragma unroll
                for (int bj = 0; bj < 2; ++bj) {
                    const f32x4 xi0 = xf32 ? __builtin_bit_cast(f32x4, raw[m2][bj][0]) : bf4lo(raw[m2][bj][0]), xi1 = xf32 ? __builtin_bit_cast(f32x4, raw[m2][bj][1]) : bf4hi(raw[m2][bj][0]);
                    f32x4 a0 = acc[ai][bj][m][0], a1 = acc[ai][bj][m][1];
                    if (bias) { a0 += *(const GAS f32x4*)(bias + col0 + bj * HALF); a1 += *(const GAS f32x4*)(bias + col0 + bj * HALF + 4); }
                    const f32x4 x0 = xi0 + ga[bj][0] * a0, x1 = xi1 + ga[bj][1] * a1;
                    const size_t o = row * 2048 + col0 + bj * HALF;
                    if (Xout32) { *(GAS f32x4*)(Xout32 + o) = x0; *(GAS f32x4*)(Xout32 + o + 4) = x1; }
                    else *(GAS u32x4*)(X + o) = (u32x4){cvt_pk_bf16(x0[0], x0[1]), cvt_pk_bf16(x0[2], x0[3]), cvt_pk_bf16(x1[0], x1[1]), cvt_pk_bf16(x1[2], x1[3])};
                    if (Hn) { const f32x4 h0 = x0 * gs[bj][0], h1 = x1 * gs[bj][1];
                        ss += ((x0[0] * x0[0] + x0[1] * x0[1]) + (x0[2] * x0[2] + x0[3] * x0[3])) + ((x1[0] * x1[0] + x1[1] * x1[1]) + (x1[2] * x1[2] + x1[3] * x1[3]));
                        *(GAS u32x4*)(Hn + o) = (u32x4){cvt_pk_bf16(h0[0], h0[1]), cvt_pk_bf16(h0[2], h0[3]), cvt_pk_bf16(h1[0], h1[1]), cvt_pk_bf16(h1[2], h1[3])}; }
                }
                if (Hn) { ss += __shfl_xor(ss, 16); ss += __shfl_xor(ss, 32); if (fq == 0) __hip_atomic_fetch_add(rsn + row, (unsigned long long)(ss * 1048576.0f), __ATOMIC_RELAXED, __HIP_MEMORY_SCOPE_AGENT); }
            }
            asm volatile("" ::: "memory");
        }
    }
};

template <class Epi, bool ALIGN_EPI>
__device__ __forceinline__ void gemm_phase(PG8_LAS unsigned char* lds, const Gemm g, const StaticOrder& S, const Epi& E) {
    int tid_ = threadIdx.x; asm volatile("" : "+v"(tid_));
    const int tid = tid_, wid = __builtin_amdgcn_readfirstlane(tid >> 6), lane = tid & 63, wr = wid >> 2, wc = wid & 3, fr = lane & 15, fq = lane >> 4;
    const int K = g.K, nt = K / BK;
    unsigned voffA[2], voffB[2];
#pragma unroll
    for (int i = 0; i < 2; ++i) { int R, C; stage_rc(tid * 16 + i * 8192, R, C); const int Rb = Epi::PERM ? ((R & ~31) + perm32(R & 31)) : R;
        voffA[i] = (unsigned)(R * g.lda + C) * 2u; voffB[i] = (unsigned)(Rb * g.ldb + C) * 2u; }
    const size_t kstep = (size_t)(BK * 2);
    const size_t hstepA = (size_t)HALF * g.lda * 2, hstepB = (size_t)HALF * g.ldb * 2;
    const unsigned ldsw = (unsigned)wid * 1024u;
    const int aoff = lds_byte(wr * 64 + fr, fq * 8), boff = lds_byte(wc * 32 + fr, fq * 8);
#define PG8_UA(u) ((const GAS char*)g.A + (size_t)(u).pm * 2 * hstepA + (g.agrp ? (size_t)((((u).pn * BM) / g.agrp) * g.agrp) * 2 : (size_t)0))
#define PG8_UB(u) ((const GAS char*)g.Bt + (size_t)(u).pn * 2 * hstepB)
#define PG8_SA(b, h) (((b) * 2 + (h)) * HTB)
#define PG8_SB(b, h) ((4 + (b) * 2 + (h)) * HTB)
#define PG8_STAGE(bufoff, gbase, voff) do { _Pragma("unroll") for (int _i = 0; _i < 2; ++_i) \
        __builtin_amdgcn_global_load_lds((const GAS unsigned*)((const GAS char*)(gbase) + (voff)[_i]), (PG8_LAS unsigned*)(lds + (bufoff) + ldsw + _i * 8192), 16, 0, 0); } while (0)
#define PG8_LDA(dst, b, h) do { _Pragma("unroll") for (int m = 0; m < 4; ++m) _Pragma("unroll") for (int k = 0; k < 2; ++k) dst[m][k] = *(const PG8_LAS bf16x8*)(lds + PG8_SA(b, h) + aoff + m * 2048 + k * 1024); } while (0)
#define PG8_LDB(dst, b, h) do { _Pragma("unroll") for (int n = 0; n < 2; ++n) _Pragma("unroll") for (int k = 0; k < 2; ++k) dst[n][k] = *(const PG8_LAS bf16x8*)(lds + PG8_SB(b, h) + boff + n * 2048 + k * 1024); } while (0)
#define PG8_MMA(ai, bj, At, Bt) do { __builtin_amdgcn_s_setprio(1); _Pragma("unroll") for (int m = 0; m < 4; ++m) _Pragma("unroll") for (int n = 0; n < 2; ++n) _Pragma("unroll") for (int k = 0; k < 2; ++k) \
        acc[ai][bj][m][n] = __builtin_amdgcn_mfma_f32_16x16x32_bf16(Bt[n][k], At[m][k], acc[ai][bj][m][n], 0, 0, 0); __builtin_amdgcn_s_setprio(0); } while (0)
#define PG8_WAIT_V(n) asm volatile("s_waitcnt vmcnt(" #n ")" ::: "memory")
#define PG8_WAIT_L(n) asm volatile("s_waitcnt lgkmcnt(" #n ")" ::: "memory")
#define PG8_BAR __builtin_amdgcn_s_barrier()
#define PG8_SCHED __builtin_amdgcn_sched_barrier(0)
    Unit cur, nxt; int ui = 0;
    if (!S.next(0, cur)) return;
    f32x4 acc[2][2][4][2];
#pragma unroll
    for (int a = 0; a < 2; ++a)
#pragma unroll
        for (int b = 0; b < 2; ++b)
#pragma unroll
            for (int m = 0; m < 4; ++m)
#pragma unroll
                for (int n = 0; n < 2; ++n) acc[a][b][m][n] = (f32x4){0.f, 0.f, 0.f, 0.f};
    bf16x8 At[4][2], B0[2][2], B1[2][2];
    const GAS char* cA = PG8_UA(cur); const GAS char* cB = PG8_UB(cur);
    PG8_STAGE(PG8_SB(0, 0), cB, voffB); PG8_STAGE(PG8_SB(0, 1), cB + hstepB, voffB); PG8_STAGE(PG8_SA(0, 0), cA, voffA); PG8_STAGE(PG8_SA(0, 1), cA + hstepA, voffA);
    if (wr == 1) PG8_BAR;
    PG8_WAIT_V(2); PG8_BAR;
    PG8_STAGE(PG8_SB(1, 0), cB + kstep, voffB); PG8_STAGE(PG8_SA(1, 0), cA + kstep, voffA); PG8_STAGE(PG8_SB(1, 1), cB + hstepB + kstep, voffB);
    PG8_WAIT_V(6); PG8_BAR;
    for (;;) {
        const bool has_next = S.next(ui + 1, nxt);
        const GAS char* nA = has_next ? PG8_UA(nxt) : cA; const GAS char* nB = has_next ? PG8_UB(nxt) : cB;
        for (int t = 0; t < nt; t += 2) {
            const bool last = (t == nt - 2);
            const GAS char* a1 = cA + (size_t)(t + 1) * kstep;
            const GAS char* a2 = last ? nA : cA + (size_t)(t + 2) * kstep; const GAS char* b2 = last ? nB : cB + (size_t)(t + 2) * kstep;
            const GAS char* a3 = a2 + kstep; const GAS char* b3 = b2 + kstep;
            PG8_LDB(B0, 0, 0); PG8_LDB(B1, 0, 1); PG8_SCHED; PG8_LDA(At, 0, 0); PG8_STAGE(PG8_SA(1, 1), a1 + hstepA, voffA);
            PG8_WAIT_V(8); PG8_WAIT_L(0); PG8_BAR; PG8_MMA(0, 0, At, B0); PG8_MMA(0, 1, At, B1); PG8_BAR; PG8_SCHED;
            PG8_LDA(At, 0, 1); PG8_STAGE(PG8_SB(0, 0), b2, voffB); PG8_STAGE(PG8_SB(0, 1), b2 + hstepB, voffB); PG8_STAGE(PG8_SA(0, 0), a2, voffA);
            PG8_WAIT_V(8); PG8_WAIT_L(0); PG8_BAR; PG8_MMA(1, 0, At, B0); PG8_MMA(1, 1, At, B1); PG8_BAR; PG8_SCHED;
            PG8_LDB(B0, 1, 0); PG8_LDB(B1, 1, 1); PG8_SCHED; PG8_LDA(At, 1, 0); PG8_STAGE(PG8_SA(0, 1), a2 + hstepA, voffA);
            PG8_WAIT_V(8); PG8_WAIT_L(0); PG8_BAR; PG8_MMA(0, 0, At, B0); PG8_MMA(0, 1, At, B1); PG8_BAR; PG8_SCHED;
            PG8_LDA(At, 1, 1); PG8_STAGE(PG8_SB(1, 0), b3, voffB); PG8_STAGE(PG8_SB(1, 1), b3 + hstepB, voffB); PG8_STAGE(PG8_SA(1, 0), a3, voffA);
            PG8_WAIT_V(8); PG8_WAIT_L(0); PG8_BAR; PG8_MMA(1, 0, At, B0); PG8_MMA(1, 1, At, B1); PG8_BAR; PG8_SCHED;
        }
        if constexpr (ALIGN_EPI) { if (wr == 0) PG8_BAR; }
        E(acc, cur, wr, wc, fr, fq);
        if (!has_next) break;
#pragma unroll
        for (int a = 0; a < 2; ++a)
#pragma unroll
            for (int b = 0; b < 2; ++b)
#pragma unroll
                for (int m = 0; m < 4; ++m)
#pragma unroll
                    for (int n = 0; n < 2; ++n) acc[a][b][m][n] = (f32x4){0.f, 0.f, 0.f, 0.f};
        cur = nxt; cA = nA; cB = nB; ++ui;
        if constexpr (ALIGN_EPI) { if (wr == 1) PG8_BAR; }
    }
    PG8_WAIT_V(0);
    if constexpr (!ALIGN_EPI) { if (wr == 0) PG8_BAR; }
    PG8_BAR;
#undef PG8_UA
#undef PG8_UB
#undef PG8_SA
#undef PG8_SB
#undef PG8_STAGE
#undef PG8_LDA
#undef PG8_LDB
#undef PG8_MMA
#undef PG8_WAIT_V
#undef PG8_WAIT_L
#undef PG8_BAR
#undef PG8_SCHED
}
}


namespace cg {
using pg8::f32x4; using pg8::bf16x8; using pg8::bf16_t; using pg8::cvt_pk_bf16;
using pg8::u32x2;
struct CEpiIn {
    GAS bf16_t* P; GAS float* Gl; const GAS float* lb; GAS bf16_t* QH; GAS bf16_t* KH; GAS bf16_t* VH; const GAS unsigned long long* rs; const GAS float* cb;
    __device__ __forceinline__ void apply(int row, int col, f32x4 v) const {
        const int seg = col >> 10;
        v = v * rsqrtf((float)rs[row] * (1.0f / (2048.0f * 1048576.0f)) + 1e-6f) + *(const GAS f32x4*)(cb + col);
        if (seg == 1 || seg == 2) {
            const f32x4 l4 = *(const GAS f32x4*)(lb + col - 1024); f32x4 g4;
#pragma unroll
            for (int j = 0; j < 4; ++j) { const float f = fminf(fmaxf(v[j], -60.f), 60.f), e = __expf(-f), sg = __builtin_amdgcn_rcpf(1.0f + e), l = l4[j];
                g4[j] = __logf(fmaxf(l + (1.0f - l) * sg, 1e-30f)); }
            const size_t ho = (size_t)(seg - 1) * pg8::HM_ELEMS + pg8::hm_off(row, (col >> 7) & 7) + (col & 127);
            *(GAS f32x4*)(Gl + ho) = g4;
        } else {
            if (seg == 4) {
#pragma unroll
                for (int j = 0; j < 4; ++j) v[j] = v[j] * pg8::sigmoidf_(v[j]);
            } else if (seg >= 5) v = pg8::gelu4(v);
            const u32x2 wv = (u32x2){cvt_pk_bf16(v[0], v[1]), cvt_pk_bf16(v[2], v[3])};
            if (seg == 0 || seg == 3) *(GAS u32x2*)((seg == 0 ? QH : VH) + pg8::hm_off(row, (col >> 7) & 7) + (col & 127)) = wv;
            else *(GAS u32x2*)(P + (size_t)row * 7168 + col) = wv;
        }
    }
};
template <int ACT> struct CEpiAct {
    GAS bf16_t* O; int ldc; const GAS unsigned long long* rs; const GAS float* cb;
    __device__ __forceinline__ void apply(int row, int col, f32x4 v) const {
        v = v * rsqrtf((float)rs[row] * (1.0f / (2048.0f * 1048576.0f)) + 1e-6f) + *(const GAS f32x4*)(cb + col);
        if (ACT == 1) {
#pragma unroll
            for (int j = 0; j < 4; ++j) { const float a = fmaxf(v[j], 0.f); v[j] = a * a; }
        }
        *(GAS u32x2*)(O + (size_t)row * ldc + col) = (u32x2){cvt_pk_bf16(v[0], v[1]), cvt_pk_bf16(v[2], v[3])};
    }
};
struct CEpiRes {
    GAS bf16_t* X; const GAS float* Xin; bool xf32;
    const GAS float* gate; const GAS float* bias; const GAS float* scale;
    GAS bf16_t* Hn; const GAS float* gsn; GAS unsigned long long* rsn;
    __device__ __forceinline__ void apply(int row, int col, f32x4 v) const {
        f32x4 ga = *(const GAS f32x4*)(gate + col);
        if (scale) ga = ga * *(const GAS f32x4*)(scale + col);
        if (bias) v = v + *(const GAS f32x4*)(bias + col);
        const size_t o = (size_t)row * 2048 + col;
        f32x4 xi;
        if (xf32) xi = *(const GAS f32x4*)(Xin + o);
        else { const u32x2 w = *(const GAS u32x2*)(X + o); xi = (f32x4){__builtin_bit_cast(float, w.x << 16), __builtin_bit_cast(float, w.x & 0xffff0000u), __builtin_bit_cast(float, w.y << 16), __builtin_bit_cast(float, w.y & 0xffff0000u)}; }
        const f32x4 x = xi + ga * v;
        *(GAS u32x2*)(X + o) = (u32x2){cvt_pk_bf16(x[0], x[1]), cvt_pk_bf16(x[2], x[3])};
        if (Hn) { const f32x4 h = x * *(const GAS f32x4*)(gsn + col); float ss = (x[0] * x[0] + x[1] * x[1]) + (x[2] * x[2] + x[3] * x[3]);
            *(GAS u32x2*)(Hn + o) = (u32x2){cvt_pk_bf16(h[0], h[1]), cvt_pk_bf16(h[2], h[3])};
            ss += __shfl_xor(ss, 16); ss += __shfl_xor(ss, 32); if ((threadIdx.x & 48) == 0) __hip_atomic_fetch_add(rsn + row, (unsigned long long)(ss * 1048576.0f), __ATOMIC_RELAXED, __HIP_MEMORY_SCOPE_AGENT); }
    }
};
template <class Epi>
__device__ __forceinline__ void ctx_gemm(PG8_LAS unsigned char* L, int bid, int G, const GAS bf16_t* A, int lda, const GAS bf16_t* Bt, int ldb, int n_lo, int n_hi, int K, int agrp, int row0, const Epi& E) {
    int tid_ = threadIdx.x; asm volatile("" : "+v"(tid_));
    const int w = __builtin_amdgcn_readfirstlane(tid_ >> 6), lane = tid_ & 63, q = lane >> 4, li = lane & 15;
    const int ncb = (n_hi - n_lo) >> 6, nitems = 8 * ncb, ksl = K >> 3, nst = ksl >> 6;
    const int xcd_ = bid & 7, slot_ = bid >> 3, cpp_ = G >> 6;
    for (int pass = 0; ; ++pass) {
        int rb, cb;
        if ((G & 63) == 0) { rb = slot_ & 7; cb = 8 * ((slot_ >> 3) + cpp_ * pass) + xcd_; if (8 * cpp_ * pass >= ncb) break; if (cb >= ncb) { asm volatile("" ::: "memory"); continue; } }
        else { const int item = bid + G * pass; if (item >= nitems) break; rb = item & 7; cb = item >> 3; }
        const int m0 = 64 * rb, n0 = n_lo + 64 * cb;
        const int acol = agrp ? (n0 / agrp) * agrp : 0;
        const GAS bf16_t* ap = A + (size_t)(m0 + li) * lda + acol + w * ksl + 8 * q;
        const GAS bf16_t* bp = Bt + (size_t)(n0 + li) * ldb + w * ksl + 8 * q;
        f32x4 acc[4][4];
#pragma unroll
        for (int rt = 0; rt < 4; ++rt)
#pragma unroll
            for (int ct = 0; ct < 4; ++ct) acc[rt][ct] = (f32x4){0.f, 0.f, 0.f, 0.f};
        bf16x8 a0[4][2], b0[4][2], a1[4][2], b1[4][2];
#define CG_LOAD(dA, dB, s) do { _Pragma("unroll") for (int t = 0; t < 4; ++t) _Pragma("unroll") for (int hh = 0; hh < 2; ++hh) { \
            dA[t][hh] = *(const GAS bf16x8*)(ap + (size_t)(16 * t) * lda + (s) * 64 + hh * 32); dB[t][hh] = *(const GAS bf16x8*)(bp + (size_t)(16 * t) * ldb + (s) * 64 + hh * 32); } } while (0)
#define CG_MMA(dA, dB) do { _Pragma("unroll") for (int hh = 0; hh < 2; ++hh) _Pragma("unroll") for (int rt = 0; rt < 4; ++rt) _Pragma("unroll") for (int ct = 0; ct < 4; ++ct) \
            acc[rt][ct] = __builtin_amdgcn_mfma_f32_16x16x32_bf16(dB[ct][hh], dA[rt][hh], acc[rt][ct], 0, 0, 0); } while (0)
        CG_LOAD(a0, b0, 0);
        for (int s = 0; s < nst; s += 2) {
            if (s + 1 < nst) CG_LOAD(a1, b1, s + 1);
            CG_MMA(a0, b0);
            if (s + 2 < nst) CG_LOAD(a0, b0, s + 2);
            if (s + 1 < nst) CG_MMA(a1, b1);
        }
#undef CG_LOAD
#undef CG_MMA
#pragma unroll
        for (int rt = 0; rt < 4; ++rt)
#pragma unroll
            for (int ct = 0; ct < 4; ++ct) *(PG8_LAS f32x4*)(L + ((w * 16 + rt * 4 + ct) * 64 + lane) * 16) = acc[rt][ct];
        asm volatile("s_waitcnt lgkmcnt(0)" ::: "memory"); __builtin_amdgcn_s_barrier(); asm volatile("" ::: "memory");
#pragma unroll
        for (int u = 0; u < 2; ++u) {
            const int tt = 2 * w + u, rt = tt >> 2, ct = tt & 3;
            f32x4 v = {0.f, 0.f, 0.f, 0.f};
#pragma unroll
            for (int ww = 0; ww < 8; ++ww) v = v + *(const PG8_LAS f32x4*)(L + ((ww * 16 + tt) * 64 + lane) * 16);
            E.apply(row0 + m0 + 16 * rt + li, n0 + 16 * ct + 4 * q, v);
        }
        asm volatile("s_waitcnt lgkmcnt(0)" ::: "memory"); __builtin_amdgcn_s_barrier(); asm volatile("" ::: "memory");
    }
}
}

constexpr int NWAVES = 8;
constexpr int D = 2048, SEQ = 8192, NLAT = 16384, CTXL = 256, NCTX = 512, MR = NLAT + NCTX;
constexpr int DFF = 8192, INC = 7168, NMOD = 12288;
constexpr float EPS = 1e-6f;

constexpr size_t MiB = 1u << 20;
constexpr size_t WS_CTL = 0, CTL_ZERO_BYTES = 3 * MiB;
constexpr size_t WS_RS = 1 * MiB;
constexpr size_t WS_MODS = 3 * MiB;
constexpr size_t WS_LB = 3 * MiB + 640 * 1024;
constexpr size_t WS_GS = 3 * MiB + 704 * 1024;
constexpr size_t WS_WIN = 4 * MiB;
constexpr size_t WS_WOUT = 60 * MiB;
constexpr size_t WS_WUP = 76 * MiB;
constexpr size_t WS_WDN = 204 * MiB;
constexpr size_t WS_WP = 332 * MiB;
constexpr size_t WS_WG = 348 * MiB;
constexpr size_t WS_X = 352 * MiB;
constexpr size_t WS_H = 484 * MiB;
constexpr size_t WS_P = 550 * MiB;
constexpr size_t WS_G = 781 * MiB;
constexpr size_t WS_OF = 913 * MiB;
constexpr size_t WS_OB = 979 * MiB;
constexpr size_t WS_Y = 1045 * MiB;
constexpr size_t WS_HID = 550 * MiB;
constexpr size_t WS_HS = 1111 * MiB;
constexpr size_t WS_DS = 1127 * MiB;
constexpr size_t WS_WSB = 1128 * MiB;
constexpr size_t WS_CB = 1129 * MiB;
constexpr size_t WS_QH = 1130 * MiB;
constexpr size_t WS_KH = 1163 * MiB;
constexpr size_t WS_VH = 1229 * MiB;
constexpr size_t WS_END = 1262 * MiB;
constexpr int CW_BAR = 4096;

constexpr int RING_BYTES = 131072;
constexpr int LDSCTL_OFF = RING_BYTES, MISC_OFF = LDSCTL_OFF + 320;
constexpr int LDS_BYTES = 147456;

#define LAS __attribute__((address_space(3)))
typedef unsigned short bf16;
typedef unsigned v4u __attribute__((ext_vector_type(4)));
typedef unsigned v2u __attribute__((ext_vector_type(2)));
typedef float f32x4 __attribute__((ext_vector_type(4)));
#define LDS_WAIT() asm volatile("s_waitcnt lgkmcnt(0)" ::: "memory")
__device__ __forceinline__ unsigned f2bf(float f) { unsigned u = __builtin_bit_cast(unsigned, f); return (u + 0x7fffu + ((u >> 16) & 1u)) >> 16; }
__device__ __forceinline__ unsigned pk2(float lo, float hi) { return f2bf(lo) | (f2bf(hi) << 16); }
__device__ __forceinline__ float bf2f(unsigned short b) { return __builtin_bit_cast(float, ((unsigned)b) << 16); }
__device__ __forceinline__ float bflo(unsigned w) { return __builtin_bit_cast(float, w << 16); }
__device__ __forceinline__ float bfhi(unsigned w) { return __builtin_bit_cast(float, w & 0xffff0000u); }

#define XB_TMO      128
#define XB_XCNT(j)  (256  + 64 * (j))
#define XB_XSUB(j)  (1280 + 64 * (j))
#define XB_XGEN(j)  (2304 + 64 * (j))
#define XB_TOP      3328
#define XB_TOPGEN   3392
#define XCD_BAR_WORDS 3456
#define XB_SPIN_CAP (1u << 18)
__device__ __forceinline__ unsigned xb_ld(unsigned* p)              { return __hip_atomic_load(p, __ATOMIC_RELAXED, __HIP_MEMORY_SCOPE_AGENT); }
__device__ __forceinline__ unsigned xb_add(unsigned* p, unsigned v) { return __hip_atomic_fetch_add(p, v, __ATOMIC_RELAXED, __HIP_MEMORY_SCOPE_AGENT); }
__device__ __forceinline__ unsigned xb_xcc_id() { return (unsigned)__builtin_amdgcn_s_getreg((3 << 11) | 20) & 0xFu; }
#define XB_SPIN(cond, bar) do { unsigned _sp = 0; while (cond) { __builtin_amdgcn_s_sleep(1); \
    if ((++_sp & 255u) == 0u) { if (xb_ld(&(bar)[XB_TMO])) break; if (_sp > XB_SPIN_CAP) { atomicAdd(&(bar)[XB_TMO], 1u); break; } } } } while (0)
struct XcdBarrier { unsigned* bar; unsigned x; volatile LAS unsigned* st; };
__device__ __forceinline__ XcdBarrier xcd_barrier_post(unsigned* bar, volatile LAS unsigned* st) {
    XcdBarrier b; b.bar = bar; b.x = xb_xcc_id(); b.st = st;
    if (threadIdx.x == 0) (void)xb_add(&bar[XB_XCNT(b.x)], 1u);
    return b;
}
__device__ __forceinline__ void xcd_barrier_complete(unsigned* bar, unsigned x, unsigned& nloc, unsigned& nx) {
    const unsigned G = gridDim.x * gridDim.y * gridDim.z;
    unsigned sum, cnt, mine, sp = 0u;
    for (;;) {
        sum = 0u; cnt = 0u; mine = 0u;
#pragma unroll
        for (unsigned j = 0; j < 16; ++j) { const unsigned c = xb_ld(&bar[XB_XCNT(j)]); sum += c; cnt += (c > 0u) ? 1u : 0u; mine = (j == x) ? c : mine; }
        if (sum == G) break;
        __builtin_amdgcn_s_sleep(1);
        if ((++sp & 255u) == 0u) { if (xb_ld(&bar[XB_TMO])) break; if (sp > XB_SPIN_CAP) { atomicAdd(&bar[XB_TMO], 1u); break; } }
    }
    nloc = mine > 0u ? mine : 1u; nx = cnt > 0u ? cnt : 1u;
}
__device__ __forceinline__ void xcd_barrier(const XcdBarrier& b) {
    asm volatile("s_waitcnt vmcnt(0)" ::: "memory");
    __syncthreads();
    if (threadIdx.x == 0) {
        unsigned* bar = b.bar;
        __builtin_amdgcn_s_waitcnt(0);
        unsigned nloc = b.st[0], nx = b.st[1];
        if (nloc == 0u) { xcd_barrier_complete(bar, b.x, nloc, nx); b.st[0] = nloc; b.st[1] = nx; }
        const unsigned old = xb_add(&bar[XB_XSUB(b.x)], 1u);
        const unsigned gen = old / nloc;
        if (old + 1u == (gen + 1u) * nloc) {
            __builtin_amdgcn_fence(__ATOMIC_RELEASE, "agent");
            asm volatile("s_waitcnt vmcnt(0)" ::: "memory");
            const unsigned og = xb_add(&bar[XB_TOP], 1u);
            const unsigned tg = og / nx;
            if (og + 1u == (tg + 1u) * nx) xb_add(&bar[XB_TOPGEN], 1u);
            else XB_SPIN(xb_ld(&bar[XB_TOPGEN]) == tg, bar);
            __builtin_amdgcn_fence(__ATOMIC_ACQUIRE, "agent");
            xb_add(&bar[XB_XGEN(b.x)], 1u);
            asm volatile("s_waitcnt vmcnt(0)" ::: "memory");
        } else {
            XB_SPIN(xb_ld(&bar[XB_XGEN(b.x)]) == gen, bar);
            __builtin_amdgcn_fence(__ATOMIC_ACQUIRE, "agent");
            asm volatile("s_waitcnt vmcnt(0)" ::: "memory");
        }
    }
    __syncthreads();
}

struct Frame {
    LAS unsigned char* lds;
    int tid, lane, wave, G, bid;
    GAS float* out;
    GAS unsigned char* ws;
};
struct Args { const float* in[22]; float* out; unsigned char* ws; int ph_lo, ph_hi; };
__device__ __forceinline__ const GAS float* in_ptr(int i) { unsigned long long p = (unsigned long long)__builtin_amdgcn_kernarg_segment_ptr(); asm volatile("" : "+s"(p)); return (const GAS float*)(((const __attribute__((address_space(4))) Args*)p)->in[i]); }
#define FRESH(F) do { asm volatile("" : "+v"(F.tid)); F.lane = F.tid & 63; F.wave = __builtin_amdgcn_readfirstlane(F.tid >> 6); asm volatile("" : "+s"(F.ws)); } while (0)
__device__ __forceinline__ float wave_sum(float v) {
#pragma unroll
    for (int o = 1; o < 64; o <<= 1) v += __shfl_xor(v, o);
    return v;
}

__device__ __forceinline__ void p0_transpose_item(const GAS float* W, int K, int N, GAS bf16* WT, LAS float* scr, int item, int lane) {
    const int nblk = N / 32, kb = item / nblk, nb = item % nblk, k0 = 64 * kb, n0 = 32 * nb;
#pragma unroll 8
    for (int i = 0; i < 32; ++i) { const int kk = 2 * i + (lane >> 5); scr[kk * 33 + (lane & 31)] = W[(size_t)(k0 + kk) * N + n0 + (lane & 31)]; }
    LDS_WAIT(); asm volatile("" ::: "memory");
    const int c = lane & 7;
#pragma unroll
    for (int j = 0; j < 4; ++j) { const int n = (lane >> 3) + 8 * j; const LAS float* s = scr + (8 * c) * 33 + n;
        v4u o; o.x = pk2(s[0 * 33], s[1 * 33]); o.y = pk2(s[2 * 33], s[3 * 33]); o.z = pk2(s[4 * 33], s[5 * 33]); o.w = pk2(s[6 * 33], s[7 * 33]);
        *(GAS v4u*)(WT + (size_t)(n0 + n) * K + k0 + 8 * c) = o; }
    LDS_WAIT(); asm volatile("" ::: "memory");
}

__device__ __forceinline__ void prologue_phase(Frame& F) {
    const int gw = F.bid * NWAVES + F.wave, NGW = F.G * NWAVES;
    {
        LAS float* scr = (LAS float*)(F.lds + 36864 + F.wave * 8448);
        constexpr int I_IN = (D / 64) * (INC / 32), I_SQ = (D / 64) * (D / 32), I_UP = (D / 64) * (DFF / 32), I_DN = (DFF / 64) * (D / 32), I_G = (512 / 64) * (512 / 32);
        constexpr int NITEMS = 2 * I_IN + 2 * I_SQ + 4 * I_UP + 4 * I_DN + 2 * I_SQ + 8 * I_G;
        for (int it = gw; it < NITEMS; it += NGW) {
            int r = it;
            if (r < 2 * I_IN) { const int e = r / I_IN; p0_transpose_item(in_ptr(8) + (size_t)e * D * INC, D, INC, (GAS bf16*)(F.ws + WS_WIN) + (size_t)e * INC * D, scr, r % I_IN, F.lane); continue; } r -= 2 * I_IN;
            if (r < 2 * I_SQ) { const int e = r / I_SQ; p0_transpose_item(in_ptr(9) + (size_t)e * D * D, D, D, (GAS bf16*)(F.ws + WS_WOUT) + (size_t)e * D * D, scr, r % I_SQ, F.lane); continue; } r -= 2 * I_SQ;
            if (r < 4 * I_UP) { const int l = r / I_UP; p0_transpose_item(in_ptr(19) + (size_t)l * D * DFF, D, DFF, (GAS bf16*)(F.ws + WS_WUP) + (size_t)l * DFF * D, scr, r % I_UP, F.lane); continue; } r -= 4 * I_UP;
            if (r < 4 * I_DN) { const int l = r / I_DN; p0_transpose_item(in_ptr(20) + (size_t)l * DFF * D, DFF, D, (GAS bf16*)(F.ws + WS_WDN) + (size_t)l * D * DFF, scr, r % I_DN, F.lane); continue; } r -= 4 * I_DN;
            if (r < 2 * I_SQ) { const int o = r / I_SQ; p0_transpose_item(in_ptr(15) + (size_t)o * D * D, D, D, (GAS bf16*)(F.ws + WS_WP) + (size_t)o * D * D, scr, r % I_SQ, F.lane); continue; } r -= 2 * I_SQ;
            { const int og = r / I_G; p0_transpose_item(in_ptr(16) + (size_t)og * 512 * 512, 512, 512, (GAS bf16*)(F.ws + WS_WG) + (size_t)og * 512 * 512, scr, r % I_G, F.lane); }
        }
    }
    {
        const GAS float* wsp = in_ptr(12); GAS bf16* wsb = (GAS bf16*)(F.ws + WS_WSB);
        for (int i = (F.bid * NWAVES * 64 + F.tid) * 4; i < 2 * 8 * 128 * 128; i += F.G * NWAVES * 64 * 4) { const f32x4 v = *(const GAS f32x4*)(wsp + i); *(GAS v2u*)(wsb + i) = (v2u){pk2(v[0], v[1]), pk2(v[2], v[3])}; }
    }
    if (F.bid == 0) {
        const GAS float* lg = in_ptr(10); GAS float* lb = (GAS float*)(F.ws + WS_LB);
        for (int i = F.tid; i < 2048; i += NWAVES * 64) {
            const int d = i >> 10, k = i & 1023;
            const float l0 = lg[(d * 2 + 0) * 1024 + k], l1 = lg[(d * 2 + 1) * 1024 + k], mx = fmaxf(l0, l1);
            const float e0 = expf(l0 - mx), e1 = expf(l1 - mx), p0 = e0 / (e0 + e1), p1 = e1 / (e0 + e1);
            lb[0 * 2048 + i] = p0 - p0; lb[1 * 2048 + i] = (p0 + p1) - p0;
        }
    }
    {
        LAS float* sv = (LAS float*)F.lds;
        LAS float* red = (LAS float*)(F.lds + 24576);
        for (int i = F.tid; i < 3 * D; i += NWAVES * 64) { const int r = i / D, k = i % D; const float x = r < 2 ? in_ptr(1)[r * D + k] : in_ptr(3)[k]; sv[i] = x / (1.0f + expf(-x)); }
        __syncthreads();
        GAS float* mods = (GAS float*)(F.ws + WS_MODS);
        const int cl = F.lane & 31, kh = F.lane >> 5;
        for (int item = F.bid; item < 4 * 96; item += F.G) {
            const int l = item / 96, n0 = (item % 96) * 128;
            const GAS float* W = in_ptr(4) + (size_t)l * D * NMOD + n0 + cl * 4;
            f32x4 a0 = {0.f, 0.f, 0.f, 0.f}, a1 = a0, a2 = a0;
#pragma unroll 8
            for (int i = 0; i < 128; ++i) {
                const int k = F.wave * 256 + 2 * i + kh;
                const f32x4 w4 = *(const GAS f32x4*)(W + (size_t)k * NMOD);
                a0 += sv[k] * w4; a1 += sv[D + k] * w4; a2 += sv[2 * D + k] * w4;
            }
#pragma unroll
            for (int j = 0; j < 4; ++j) { a0[j] += __shfl_xor(a0[j], 32); a1[j] += __shfl_xor(a1[j], 32); a2[j] += __shfl_xor(a2[j], 32); }
            if (F.lane < 32) { *(LAS f32x4*)(red + (F.wave * 3 + 0) * 128 + cl * 4) = a0; *(LAS f32x4*)(red + (F.wave * 3 + 1) * 128 + cl * 4) = a1; *(LAS f32x4*)(red + (F.wave * 3 + 2) * 128 + cl * 4) = a2; }
            __syncthreads();
            if (F.tid < 384) { const int r = F.tid / 128, c = F.tid % 128; float s = 0.f;
#pragma unroll
                for (int w = 0; w < 8; ++w) s += red[(w * 3 + r) * 128 + c];
                mods[(size_t)(l * 3 + r) * NMOD + n0 + c] = s + in_ptr(5)[(size_t)l * NMOD + n0 + c]; }
            __syncthreads();
        }
    }
}

__device__ __forceinline__ void prep_phase(Frame& F) {
    const int gw = F.bid * NWAVES + F.wave, NGW = F.G * NWAVES;
    const GAS float* mods = (const GAS float*)(F.ws + WS_MODS);
    {
        GAS bf16* H = (GAS bf16*)(F.ws + WS_H); GAS unsigned long long* RS = (GAS unsigned long long*)(F.ws + WS_RS);
        const GAS float* gvec = in_ptr(6);
        for (int row = gw; row < MR; row += NGW) {
            const GAS float* xr = row < NLAT ? in_ptr(0) + (size_t)row * D : in_ptr(2) + (size_t)(row - NLAT) * D;
            const int mr = row < SEQ ? 0 : (row < NLAT ? 1 : 2);
            f32x4 v[8]; float ss = 0.f;
#pragma unroll
            for (int j = 0; j < 8; ++j) { v[j] = *(const GAS f32x4*)(xr + 4 * (F.lane + 64 * j)); ss += (v[j][0] * v[j][0] + v[j][1] * v[j][1]) + (v[j][2] * v[j][2] + v[j][3] * v[j][3]); }
            ss = wave_sum(ss);
            if (F.lane == 0) RS[row] = (unsigned long long)(ss * 1048576.0f);
#pragma unroll
            for (int j = 0; j < 8; ++j) {
                const int col = 4 * (F.lane + 64 * j);
                const f32x4 g4 = *(const GAS f32x4*)(gvec + col), s4 = *(const GAS f32x4*)(mods + (size_t)mr * NMOD + 2048 + col);
                const f32x4 y = v[j] * g4 * (1.0f + s4);
                v2u w; w.x = pk2(y[0], y[1]); w.y = pk2(y[2], y[3]);
                *(GAS v2u*)(H + (size_t)row * D + col) = w;
            }
        }
    }
    {
        GAS float* GS = (GAS float*)(F.ws + WS_GS);
        for (int i = F.bid * NWAVES * 64 + F.tid; i < 4 * 2 * 3 * D; i += F.G * NWAVES * 64) {
            const int col = i % D, mr = (i / D) % 3, j = (i / (3 * D)) % 2, L = i / (6 * D);
            const float g = (j ? in_ptr(7) : in_ptr(6))[(size_t)L * D + col], sc = mods[((size_t)L * 3 + mr) * NMOD + (j ? 8192 : 2048) + col];
            GS[i] = g * (1.0f + sc);
        }
    }
    {
        GAS float* CB = (GAS float*)(F.ws + WS_CB);
        for (int L = 0; L < 4; ++L)
            for (int j = 0; j < 2; ++j) {
                const int N = j ? DFF : ((L & 1) ? D : INC);
                const GAS bf16* WT = j ? (const GAS bf16*)(F.ws + WS_WUP) + (size_t)L * DFF * D : ((L & 1) ? (const GAS bf16*)(F.ws + WS_WP) + (size_t)(L >> 1) * D * D : (const GAS bf16*)(F.ws + WS_WIN) + (size_t)(L >> 1) * INC * D);
                const GAS float* sh = mods + (size_t)L * 3 * NMOD + (j ? 6144 : 0);
                f32x4 s0[8], s1[8], s2[8];
#pragma unroll
                for (int jj = 0; jj < 4; ++jj)
#pragma unroll
                    for (int h2 = 0; h2 < 2; ++h2) { const int k = 8 * F.lane + 512 * jj + 4 * h2;
                        s0[2 * jj + h2] = *(const GAS f32x4*)(sh + k); s1[2 * jj + h2] = *(const GAS f32x4*)(sh + NMOD + k); s2[2 * jj + h2] = *(const GAS f32x4*)(sh + 2 * NMOD + k); }
                for (int n = gw; n < N; n += NGW) {
                    float a0 = 0.f, a1 = 0.f, a2 = 0.f;
                    v4u wv[4];
#pragma unroll
                    for (int jj = 0; jj < 4; ++jj) wv[jj] = *(const GAS v4u*)(WT + (size_t)n * D + 8 * F.lane + 512 * jj);
#pragma unroll
                    for (int jj = 0; jj < 4; ++jj) {
                        const float wf[8] = {bflo(wv[jj].x), bfhi(wv[jj].x), bflo(wv[jj].y), bfhi(wv[jj].y), bflo(wv[jj].z), bfhi(wv[jj].z), bflo(wv[jj].w), bfhi(wv[jj].w)};
#pragma unroll
                        for (int h2 = 0; h2 < 2; ++h2)
#pragma unroll
                            for (int u = 0; u < 4; ++u) { a0 += s0[2 * jj + h2][u] * wf[4 * h2 + u]; a1 += s1[2 * jj + h2][u] * wf[4 * h2 + u]; a2 += s2[2 * jj + h2][u] * wf[4 * h2 + u]; }
                    }
                    a0 = wave_sum(a0); a1 = wave_sum(a1); a2 = wave_sum(a2);
                    if (F.lane == 0) { GAS float* o = CB + (size_t)L * 3 * 16384 + (j ? 8192 : 0) + n; o[0] = a0; o[16384] = a1; o[2 * 16384] = a2; }
                }
            }
    }
}
__device__ __forceinline__ void final_norm_phase(Frame& F) {
    const int gw = F.bid * NWAVES + F.wave, NGW = F.G * NWAVES;
    const GAS float* gvec = in_ptr(21);
    for (int row = gw; row < NLAT; row += NGW) {
        GAS float* xr = F.out + (size_t)row * D;
        f32x4 v[8]; float ss = 0.f;
#pragma unroll
        for (int j = 0; j < 8; ++j) { v[j] = *(const GAS f32x4*)(xr + 4 * (F.lane + 64 * j)); ss += (v[j][0] * v[j][0] + v[j][1] * v[j][1]) + (v[j][2] * v[j][2] + v[j][3] * v[j][3]); }
        const float rstd = rsqrtf(wave_sum(ss) * (1.0f / D) + EPS);
#pragma unroll
        for (int j = 0; j < 8; ++j) { const int col = 4 * (F.lane + 64 * j); *(GAS f32x4*)(xr + col) = (v[j] * rstd) * *(const GAS f32x4*)(gvec + col); }
    }
}

constexpr int SC_RS = 272, SC_TS = 144;
constexpr int SC_QB = 0, SC_QS = 17408, SC_KS0 = 34816, SC_KS1 = SC_KS0 + 16 * SC_RS, SC_KS2 = SC_KS1 + 32 * SC_RS, SC_KS3 = SC_KS2 + 48 * SC_RS;
constexpr int SC_KST = SC_KS3 + 64 * SC_RS, SC_VT = SC_KST + 128 * SC_TS, SC_A = SC_VT + 128 * SC_TS, SC_TOT = SC_A + 64 * SC_TS, SC_D = SC_TOT + 4096, SC_END = SC_D + 512;
static_assert(SC_END <= RING_BYTES, "scan LDS map");
#define SC_LBAR() do { asm volatile("s_waitcnt lgkmcnt(0)" ::: "memory"); __builtin_amdgcn_s_barrier(); asm volatile("" ::: "memory"); } while (0)
typedef short bf16x8_t __attribute__((ext_vector_type(8)));
typedef float f32x2_t __attribute__((ext_vector_type(2)));
__device__ __forceinline__ unsigned cvtpk(float lo, float hi) { return pg8::cvt_pk_bf16(lo, hi); }

template <bool STATE_ONLY>
__device__ __forceinline__ void scan_fast_phase(Frame& F) {
    const GAS float* Gl = (const GAS float*)(F.ws + WS_G);
    const GAS bf16* QH = (const GAS bf16*)(F.ws + WS_QH); const GAS bf16* VH = (const GAS bf16*)(F.ws + WS_VH);
    GAS float* HS = (GAS float*)(F.ws + WS_HS); GAS float* DS = (GAS float*)(F.ws + WS_DS);
    LAS unsigned char* L = F.lds;
    const int w = F.wave, lane = F.lane, q = lane >> 4, li = lane & 15;
    if (!STATE_ONLY) { for (int u = F.tid; u < (64 * SC_TS) / 4; u += NWAVES * 64) ((LAS unsigned*)(L + SC_A))[u] = 0u; }
    for (int item = F.bid; item < 256; item += F.G) {
        const int seq = item >> 3, seg = item & 7, b = seq >> 4, h = (seq >> 1) & 7, dir = seq & 1;
        const int cs = seg < 4 ? 17 * seg : 68 + 16 * (seg - 4), ce = seg < 4 ? 17 * (seg + 1) : 68 + 16 * (seg - 3);
        f32x4 S[8];
#pragma unroll
        for (int kt = 0; kt < 8; ++kt) S[kt] = (f32x4){0.f, 0.f, 0.f, 0.f};
        if (!STATE_ONLY) {
            for (int jj = 0; jj < seg; ++jj) {
                const GAS float* hp = HS + ((size_t)((seq * 8 + jj) * 8 + w) * 64 + lane) * 32; const GAS float* dp = DS + (size_t)(seq * 8 + jj) * 128;
#pragma unroll
                for (int kt = 0; kt < 8; ++kt) { const f32x4 hv = *(const GAS f32x4*)(hp + 4 * kt), dv = *(const GAS f32x4*)(dp + 16 * kt + 4 * q); S[kt] = dv * S[kt] + hv; }
            }
        }
        float segtot0 = 0.f, segtot1 = 0.f;
        f32x2_t gx[8]; unsigned qw[8], vw[8];
#define SC_LOAD(ci_) do { const int ci__ = (ci_); const int p0 = ci__ < 4 ? 64 * ci__ : 64 * (ci__ - 4); \
        const size_t hb = ci__ < 4 ? (size_t)16 * SEQ * 128 + ((size_t)((b * 8 + h) * CTXL + (dir ? CTXL - 1 - p0 : p0))) * 128 : ((size_t)((b * 8 + h) * SEQ + (dir ? SEQ - 1 - p0 : p0))) * 128; \
        _Pragma("unroll") for (int r = 0; r < 8; ++r) { const size_t eo = dir ? hb - (size_t)(8 * w + r) * 128 + 2 * lane : hb + (size_t)(8 * w + r) * 128 + 2 * lane; \
            gx[r] = *(const GAS f32x2_t*)(Gl + (size_t)dir * pg8::HM_ELEMS + eo); \
            vw[r] = *(const GAS unsigned*)(VH + eo); \
            if (!STATE_ONLY) qw[r] = *(const GAS unsigned*)(QH + eo); } } while (0)
        SC_LOAD(cs);
        for (int ci = cs; ci < ce; ++ci) {
            float l0[8], l1[8], kf0[8], kf1[8];
            { float a0 = 0.f, a1 = 0.f;
#pragma unroll
              for (int r = 0; r < 8; ++r) { a0 += gx[r][0]; a1 += gx[r][1]; l0[r] = a0; l1[r] = a1; kf0[r] = 1.0f - __expf(gx[r][0]); kf1[r] = 1.0f - __expf(gx[r][1]); }
              *(LAS f32x2_t*)(L + SC_TOT + (w * 128 + 2 * lane) * 4) = (f32x2_t){a0, a1}; }
            SC_LBAR();
            float rr0[5], rr1[5], pre0 = 0.f, pre1 = 0.f;
            { float s0 = 0.f, s1 = 0.f; rr0[0] = 0.f; rr1[0] = 0.f;
#pragma unroll
              for (int ww = 0; ww < 8; ++ww) { const f32x2_t t = *(const LAS f32x2_t*)(L + SC_TOT + (ww * 128 + 2 * lane) * 4); if (ww == w) { pre0 = s0; pre1 = s1; } s0 += t[0]; s1 += t[1]; if (ww & 1) { rr0[(ww + 1) >> 1] = s0; rr1[(ww + 1) >> 1] = s1; } } }
            const int c = w >> 1;
            float rc0 = 0.f, rc1 = 0.f, rn0 = 0.f, rn1 = 0.f;
#pragma unroll
            for (int cc = 0; cc < 4; ++cc) if (cc == c) { rc0 = rr0[cc]; rc1 = rr1[cc]; rn0 = rr0[cc + 1]; rn1 = rr1[cc + 1]; }
            if (STATE_ONLY) {
                unsigned k0p[4], k1p[4], v0p[4], v1p[4];
#pragma unroll
                for (int r = 0; r < 8; r += 2) {
                    const float fa0 = __expf(rr0[4] - (pre0 + l0[r])), fa1 = __expf(rr1[4] - (pre1 + l1[r])), fb0 = __expf(rr0[4] - (pre0 + l0[r + 1])), fb1 = __expf(rr1[4] - (pre1 + l1[r + 1]));
                    k0p[r >> 1] = cvtpk(kf0[r] * fa0, kf0[r + 1] * fb0); k1p[r >> 1] = cvtpk(kf1[r] * fa1, kf1[r + 1] * fb1);
                    v0p[r >> 1] = (vw[r] & 0xffffu) | (vw[r + 1] << 16); v1p[r >> 1] = (vw[r] >> 16) | (vw[r + 1] & 0xffff0000u);
                }
                *(LAS v4u*)(L + SC_KST + (2 * lane) * SC_TS + 16 * w) = (v4u){k0p[0], k0p[1], k0p[2], k0p[3]}; *(LAS v4u*)(L + SC_KST + (2 * lane + 1) * SC_TS + 16 * w) = (v4u){k1p[0], k1p[1], k1p[2], k1p[3]};
                *(LAS v4u*)(L + SC_VT + (2 * lane) * SC_TS + 16 * w) = (v4u){v0p[0], v0p[1], v0p[2], v0p[3]}; *(LAS v4u*)(L + SC_VT + (2 * lane + 1) * SC_TS + 16 * w) = (v4u){v1p[0], v1p[1], v1p[2], v1p[3]};
                if (w == 0) *(LAS f32x2_t*)(L + SC_D + 8 * lane) = (f32x2_t){__expf(rr0[4]), __expf(rr1[4])};
                segtot0 += rr0[4]; segtot1 += rr1[4];
            } else {
                const float R0 = __expf(rc0), R1 = __expf(rc1);
                float T0[5], T1[5];
#pragma unroll
                for (int cp = 1; cp < 5; ++cp) { T0[cp] = __expf(rr0[cp] - rn0); T1[cp] = __expf(rr1[cp] - rn1); }
                unsigned k0p[4], k1p[4], v0p[4], v1p[4];
#pragma unroll
                for (int r = 0; r < 8; ++r) {
                    const int i = 8 * w + r;
                    const float B0 = pre0 + l0[r], B1 = pre1 + l1[r];
                    const float E0 = __expf(B0 - rc0), E1 = __expf(B1 - rc1), F0 = __expf(rn0 - B0), F1 = __expf(rn1 - B1), D0 = __expf(fminf(rc0 - B0, 80.f)), D1 = __expf(fminf(rc1 - B1, 80.f));
                    const float q0 = bflo(qw[r]) * E0, q1 = bfhi(qw[r]) * E1, k0 = kf0[r], k1 = kf1[r];
                    *(LAS unsigned*)(L + SC_QS + i * SC_RS + 4 * lane) = cvtpk(q0, q1);
                    *(LAS unsigned*)(L + SC_QB + i * SC_RS + 4 * lane) = cvtpk(q0 * R0, q1 * R1);
                    const float kf0 = k0 * F0, kf1 = k1 * F1;
                    const unsigned kd = cvtpk(k0 * D0, k1 * D1);
                    if (c == 0) { *(LAS unsigned*)(L + SC_KS0 + i * SC_RS + 4 * lane) = kd; *(LAS unsigned*)(L + SC_KS1 + i * SC_RS + 4 * lane) = cvtpk(kf0 * T0[1], kf1 * T1[1]); *(LAS unsigned*)(L + SC_KS2 + i * SC_RS + 4 * lane) = cvtpk(kf0 * T0[2], kf1 * T1[2]); *(LAS unsigned*)(L + SC_KS3 + i * SC_RS + 4 * lane) = cvtpk(kf0 * T0[3], kf1 * T1[3]); }
                    else if (c == 1) { *(LAS unsigned*)(L + SC_KS1 + i * SC_RS + 4 * lane) = kd; *(LAS unsigned*)(L + SC_KS2 + i * SC_RS + 4 * lane) = cvtpk(kf0 * T0[2], kf1 * T1[2]); *(LAS unsigned*)(L + SC_KS3 + i * SC_RS + 4 * lane) = cvtpk(kf0 * T0[3], kf1 * T1[3]); }
                    else if (c == 2) { *(LAS unsigned*)(L + SC_KS2 + i * SC_RS + 4 * lane) = kd; *(LAS unsigned*)(L + SC_KS3 + i * SC_RS + 4 * lane) = cvtpk(kf0 * T0[3], kf1 * T1[3]); }
                    else { *(LAS unsigned*)(L + SC_KS3 + i * SC_RS + 4 * lane) = kd; }
                    const float ks0 = kf0 * T0[4], ks1 = kf1 * T1[4];
                    if (r & 1) { k0p[r >> 1] |= (cvtpk(ks0, ks0) << 16); k1p[r >> 1] |= (cvtpk(ks1, ks1) << 16); v0p[r >> 1] |= (vw[r] << 16); v1p[r >> 1] |= (vw[r] & 0xffff0000u); }
                    else { k0p[r >> 1] = cvtpk(ks0, ks0) & 0xffffu; k1p[r >> 1] = cvtpk(ks1, ks1) & 0xffffu; v0p[r >> 1] = vw[r] & 0xffffu; v1p[r >> 1] = vw[r] >> 16; }
                }
                *(LAS v4u*)(L + SC_KST + (2 * lane) * SC_TS + 16 * w) = (v4u){k0p[0], k0p[1], k0p[2], k0p[3]}; *(LAS v4u*)(L + SC_KST + (2 * lane + 1) * SC_TS + 16 * w) = (v4u){k1p[0], k1p[1], k1p[2], k1p[3]};
                *(LAS v4u*)(L + SC_VT + (2 * lane) * SC_TS + 16 * w) = (v4u){v0p[0], v0p[1], v0p[2], v0p[3]}; *(LAS v4u*)(L + SC_VT + (2 * lane + 1) * SC_TS + 16 * w) = (v4u){v1p[0], v1p[1], v1p[2], v1p[3]};
                if (w == 0) *(LAS f32x2_t*)(L + SC_D + 8 * lane) = (f32x2_t){__expf(rr0[4]), __expf(rr1[4])};
            }
            const int p0c = ci < 4 ? 64 * ci : 64 * (ci - 4);
            const long orow0 = ci < 4 ? (long)NLAT + b * CTXL + (dir ? CTXL - 1 - p0c : p0c) : (long)b * SEQ + (dir ? SEQ - 1 - p0c : p0c);
            if (ci + 1 < ce) SC_LOAD(ci + 1);
            SC_LBAR();
            f32x4 O[4];
            if (!STATE_ONLY) {
#pragma unroll
                for (int rep = 0; rep < 2; ++rep) {
                    const int blk = w + 8 * rep;
                    if (blk < 10) {
                        const int cq = blk < 1 ? 0 : (blk < 3 ? 1 : (blk < 6 ? 2 : 3)), ck = blk - (cq * (cq + 1)) / 2;
                        const int ksoff = cq == 0 ? SC_KS0 : (cq == 1 ? SC_KS1 : (cq == 2 ? SC_KS2 : SC_KS3));
                        f32x4 acc = {0.f, 0.f, 0.f, 0.f};
#pragma unroll
                        for (int kk = 0; kk < 4; ++kk) {
                            const bf16x8_t a = *(const LAS bf16x8_t*)(L + ksoff + (16 * ck + li) * SC_RS + kk * 64 + q * 16);
                            const bf16x8_t bq = *(const LAS bf16x8_t*)(L + SC_QS + (16 * cq + li) * SC_RS + kk * 64 + q * 16);
                            acc = __builtin_amdgcn_mfma_f32_16x16x32_bf16(a, bq, acc, 0, 0, 0);
                        }
                        if (cq == ck) {
#pragma unroll
                            for (int r = 0; r < 4; ++r) if (4 * q + r > li) acc[r] = 0.f;
                        }
                        *(LAS v2u*)(L + SC_A + (16 * cq + li) * SC_TS + (16 * ck + 4 * q) * 2) = (v2u){cvtpk(acc[0], acc[1]), cvtpk(acc[2], acc[3])};
                    }
                }
#pragma unroll
                for (int it = 0; it < 4; ++it) O[it] = (f32x4){0.f, 0.f, 0.f, 0.f};
#pragma unroll
                for (int kk = 0; kk < 4; ++kk) {
                    const v4u sb = (v4u){cvtpk(S[2 * kk][0], S[2 * kk][1]), cvtpk(S[2 * kk][2], S[2 * kk][3]), cvtpk(S[2 * kk + 1][0], S[2 * kk + 1][1]), cvtpk(S[2 * kk + 1][2], S[2 * kk + 1][3])};
                    const bf16x8_t bs = __builtin_bit_cast(bf16x8_t, sb);
#pragma unroll
                    for (int it = 0; it < 4; ++it) {
                        const v2u a_lo = *(const LAS v2u*)(L + SC_QB + (16 * it + li) * SC_RS + kk * 64 + q * 8), a_hi = *(const LAS v2u*)(L + SC_QB + (16 * it + li) * SC_RS + kk * 64 + 32 + q * 8);
                        const bf16x8_t a = __builtin_bit_cast(bf16x8_t, (v4u){a_lo.x, a_lo.y, a_hi.x, a_hi.y});
                        O[it] = __builtin_amdgcn_mfma_f32_16x16x32_bf16(a, bs, O[it], 0, 0, 0);
                    }
                }
                SC_LBAR();
            }
            bf16x8_t bv[2];
#pragma unroll
            for (int is = 0; is < 2; ++is) bv[is] = *(const LAS bf16x8_t*)(L + SC_VT + (16 * w + li) * SC_TS + is * 64 + q * 16);
            if (!STATE_ONLY) {
#pragma unroll
                for (int it = 0; it < 4; ++it)
#pragma unroll
                    for (int ks = 0; ks < 2; ++ks) if (ks == 0 || it >= 2) {
                        const bf16x8_t a = *(const LAS bf16x8_t*)(L + SC_A + (16 * it + li) * SC_TS + ks * 64 + q * 16);
                        O[it] = __builtin_amdgcn_mfma_f32_16x16x32_bf16(a, bv[ks], O[it], 0, 0, 0);
                    }
                GAS float* Od = (GAS float*)(F.ws + (dir ? WS_OB : WS_OF));
#pragma unroll
                for (int it = 0; it < 4; ++it)
#pragma unroll
                    for (int r = 0; r < 4; ++r) { const int i = 16 * it + 4 * q + r; const long row = orow0 + (dir ? -i : i); Od[row * 1024 + h * 128 + 16 * w + li] = O[it][r]; }
            }
#pragma unroll
            for (int kt = 0; kt < 8; ++kt) {
                const f32x4 dv = *(const LAS f32x4*)(L + SC_D + (16 * kt + 4 * q) * 4);
                S[kt] = S[kt] * dv;
#pragma unroll
                for (int is = 0; is < 2; ++is) {
                    const bf16x8_t a = *(const LAS bf16x8_t*)(L + SC_KST + (16 * kt + li) * SC_TS + is * 64 + q * 16);
                    S[kt] = __builtin_amdgcn_mfma_f32_16x16x32_bf16(a, bv[is], S[kt], 0, 0, 0);
                }
            }
        }
#undef SC_LOAD
        if (STATE_ONLY) {
            GAS float* hp = HS + ((size_t)((seq * 8 + seg) * 8 + w) * 64 + lane) * 32;
#pragma unroll
            for (int kt = 0; kt < 8; ++kt) *(GAS f32x4*)(hp + 4 * kt) = S[kt];
            if (w == 0) *(GAS f32x2_t*)(DS + (size_t)(seq * 8 + seg) * 128 + 2 * lane) = (f32x2_t){__expf(segtot0), __expf(segtot1)};
        }
        SC_LBAR();
    }
}

__device__ __forceinline__ void readout_phase(Frame& F, int e, int nrows) {
    const GAS bf16* P = (const GAS bf16*)(F.ws + WS_P); GAS bf16* Y = (GAS bf16*)(F.ws + WS_Y);
    {
        const GAS float* OF = (const GAS float*)(F.ws + WS_OF); const GAS float* OB = (const GAS float*)(F.ws + WS_OB); const GAS float* ng = in_ptr(11) + (size_t)e * 1024;
        const int gw = F.bid * NWAVES + F.wave, NGW = F.G * NWAVES;
        for (int row = gw; row < nrows; row += NGW) {
            const int col = 16 * F.lane; f32x4 o[4]; float ss = 0.f;
#pragma unroll
            for (int j = 0; j < 4; ++j) { o[j] = *(const GAS f32x4*)(OF + (size_t)row * 1024 + col + 4 * j) + *(const GAS f32x4*)(OB + (size_t)row * 1024 + col + 4 * j);
                ss += (o[j][0] * o[j][0] + o[j][1] * o[j][1]) + (o[j][2] * o[j][2] + o[j][3] * o[j][3]); }
            ss += __shfl_xor(ss, 1); ss += __shfl_xor(ss, 2); ss += __shfl_xor(ss, 4);
            const float r = rsqrtf(ss * (1.0f / 128.0f) + EPS);
            const v4u s0 = *(const GAS v4u*)(P + (size_t)row * INC + 4096 + col), s1 = *(const GAS v4u*)(P + (size_t)row * INC + 4096 + col + 8);
            const float sgv[16] = {bflo(s0.x), bfhi(s0.x), bflo(s0.y), bfhi(s0.y), bflo(s0.z), bfhi(s0.z), bflo(s0.w), bfhi(s0.w), bflo(s1.x), bfhi(s1.x), bflo(s1.y), bfhi(s1.y), bflo(s1.z), bfhi(s1.z), bflo(s1.w), bfhi(s1.w)};
            float y[16];
#pragma unroll
            for (int j = 0; j < 4; ++j) { const f32x4 g4 = *(const GAS f32x4*)(ng + col + 4 * j);
#pragma unroll
                for (int q = 0; q < 4; ++q) y[4 * j + q] = o[j][q] * r * g4[q] * sgv[4 * j + q]; }
            v4u w0, w1; w0.x = pk2(y[0], y[1]); w0.y = pk2(y[2], y[3]); w0.z = pk2(y[4], y[5]); w0.w = pk2(y[6], y[7]); w1.x = pk2(y[8], y[9]); w1.y = pk2(y[10], y[11]); w1.z = pk2(y[12], y[13]); w1.w = pk2(y[14], y[15]);
            *(GAS v4u*)(Y + (size_t)row * D + col) = w0; *(GAS v4u*)(Y + (size_t)row * D + col + 8) = w1;
        }
    }
}
__device__ __forceinline__ void spatial_mfma_phase(Frame& F, int e, int nchunks) {
    const GAS bf16* P = (const GAS bf16*)(F.ws + WS_P); GAS bf16* Y = (GAS bf16*)(F.ws + WS_Y);
    LAS unsigned char* L = F.lds; constexpr int VP = 272;
    const GAS float* gv = in_ptr(14) + (size_t)e * 1024; const GAS float* bsp = in_ptr(13) + (size_t)e * 1024;
    const GAS bf16* wsb = (const GAS bf16*)(F.ws + WS_WSB) + (size_t)e * 8 * 128 * 128;
    const int w = F.wave, lane = F.lane, q = lane >> 4, li = lane & 15;
    const int nitems = nchunks * 8;
    if (F.bid >= nitems) return;
    const bool gfix = (F.G & 7) == 0; const int g0 = F.bid & 7;
    bf16x8_t wf[4];
#pragma unroll
    for (int ks = 0; ks < 4; ++ks) wf[ks] = *(const GAS bf16x8_t*)(wsb + ((size_t)g0 * 128 + 16 * w + li) * 128 + 32 * ks + 8 * q);
    unsigned xr[16];
#define SP_LOAD(item_) do { const int n_ = (item_) >> 3, g_ = (item_) & 7; const size_t rb_ = n_ < 128 ? (size_t)n_ * 128 : (size_t)NLAT + (size_t)(n_ - 128) * 128; \
        _Pragma("unroll") for (int i = 0; i < 16; ++i) xr[i] = *(const GAS unsigned*)(P + (rb_ + 16 * w + i) * INC + 6144 + g_ * 128 + 2 * lane); } while (0)
    SP_LOAD(F.bid);
    for (int item = F.bid; item < nitems; item += F.G) {
        const int n = item >> 3, g = item & 7; const size_t rowbase = n < 128 ? (size_t)n * 128 : (size_t)NLAT + (size_t)(n - 128) * 128;
        const float gva = gv[g * 128 + 2 * lane], gvb = gv[g * 128 + 2 * lane + 1];
        float s1[16], s2[16], x0[16], x1[16];
#pragma unroll
        for (int i = 0; i < 16; ++i) { x0[i] = bflo(xr[i]); x1[i] = bfhi(xr[i]); s1[i] = x0[i] + x1[i]; s2[i] = x0[i] * x0[i] + x1[i] * x1[i]; }
#pragma unroll
        for (int o = 1; o < 64; o <<= 1)
#pragma unroll
            for (int i = 0; i < 16; ++i) { s1[i] += __shfl_xor(s1[i], o); s2[i] += __shfl_xor(s2[i], o); }
#pragma unroll
        for (int i = 0; i < 16; i += 2) {
            const int s = 16 * w + i;
            const float ma = s1[i] * (1.0f / 128.0f), mb = s1[i + 1] * (1.0f / 128.0f);
            const float ra = rsqrtf(fmaxf(s2[i] * (1.0f / 128.0f) - ma * ma, 0.f) + EPS), rb = rsqrtf(fmaxf(s2[i + 1] * (1.0f / 128.0f) - mb * mb, 0.f) + EPS);
            *(LAS unsigned*)(L + (2 * lane) * VP + 2 * s) = cvtpk((x0[i] - ma) * ra * gva, (x0[i + 1] - mb) * rb * gva);
            *(LAS unsigned*)(L + (2 * lane + 1) * VP + 2 * s) = cvtpk((x1[i] - ma) * ra * gvb, (x1[i + 1] - mb) * rb * gvb);
        }
        if (item + F.G < nitems) SP_LOAD(item + F.G);
        __syncthreads();
        f32x4 acc[8];
#pragma unroll
        for (int ct = 0; ct < 8; ++ct) acc[ct] = (f32x4){0.f, 0.f, 0.f, 0.f};
#pragma unroll
        for (int ks = 0; ks < 4; ++ks) {
            const bf16x8_t wfk = gfix ? wf[ks] : *(const GAS bf16x8_t*)(wsb + ((size_t)g * 128 + 16 * w + li) * 128 + 32 * ks + 8 * q);
#pragma unroll
            for (int ct = 0; ct < 8; ++ct) {
                const bf16x8_t vf = *(const LAS bf16x8_t*)(L + (16 * ct + li) * VP + 64 * ks + 16 * q);
                acc[ct] = __builtin_amdgcn_mfma_f32_16x16x32_bf16(vf, wfk, acc[ct], 0, 0, 0);
            }
        }
        const int t = 16 * w + li; const float bias = bsp[g * 128 + t]; const size_t row = rowbase + t;
        v2u uw[8];
#pragma unroll
        for (int ct = 0; ct < 8; ++ct) uw[ct] = *(const GAS v2u*)(P + row * INC + 5120 + g * 128 + 16 * ct + 4 * q);
#pragma unroll
        for (int ct = 0; ct < 8; ++ct) {
            const int c = 16 * ct + 4 * q;
            *(GAS v2u*)(Y + row * D + 1024 + g * 128 + c) = (v2u){cvtpk(bflo(uw[ct].x) * (acc[ct][0] + bias), bfhi(uw[ct].x) * (acc[ct][1] + bias)), cvtpk(bflo(uw[ct].y) * (acc[ct][2] + bias), bfhi(uw[ct].y) * (acc[ct][3] + bias))};
        }
        __syncthreads();
    }
#undef SP_LOAD
}

__device__ __forceinline__ void pool_fast_phase(Frame& F, bool with_ctx) {
    const GAS bf16* PP = (const GAS bf16*)(F.ws + WS_P); GAS bf16* Y = (GAS bf16*)(F.ws + WS_Y);
    LAS float* vs = (LAS float*)F.lds;
    for (int br0 = F.bid; br0 < 256; br0 += F.G) {
        const int br = (F.G == 256) ? ((br0 & 7) * 32 + (br0 >> 3)) : br0;
        const int b = br >> 7, r = br & 127;
#pragma unroll 1
        for (int cblk = 0; cblk < 8; ++cblk) {
            const int g = cblk >> 1, k = 2 << g, half = k >> 1;
            const int rlo = max(r - half, 0), rhi = min(r - half + k, 128);
            unsigned lofs[4]; float s[4][8];
#pragma unroll
            for (int j = 0; j < 4; ++j) { const int idx = F.tid + 512 * j; lofs[j] = (unsigned)((b * SEQ + (idx >> 5)) * D + cblk * 256 + (idx & 31) * 8);
#pragma unroll
                for (int u = 0; u < 8; ++u) s[j][u] = 0.f; }
#pragma unroll 4
            for (int rr = rlo; rr < rhi; ++rr) {
                const unsigned ro = (unsigned)rr * (unsigned)(64 * D);
#pragma unroll
                for (int j = 0; j < 4; ++j) { const v4u x = *(const GAS v4u*)(PP + (lofs[j] + ro));
                    s[j][0] += bflo(x.x); s[j][1] += bfhi(x.x); s[j][2] += bflo(x.y); s[j][3] += bfhi(x.y); s[j][4] += bflo(x.z); s[j][5] += bfhi(x.z); s[j][6] += bflo(x.w); s[j][7] += bfhi(x.w); }
            }
#pragma unroll
            for (int j = 0; j < 4; ++j) { const int idx = F.tid + 512 * j, c = idx >> 5, vec = idx & 31;
                *(LAS f32x4*)(vs + c * 256 + vec * 8) = (f32x4){s[j][0], s[j][1], s[j][2], s[j][3]}; *(LAS f32x4*)(vs + c * 256 + vec * 8 + 4) = (f32x4){s[j][4], s[j][5], s[j][6], s[j][7]}; }
            __syncthreads();
            v4u sf[4];
#pragma unroll
            for (int j = 0; j < 4; ++j) sf[j] = *(const GAS v4u*)(PP + (lofs[j] + (unsigned)r * (unsigned)(64 * D)));
#pragma unroll
            for (int j = 0; j < 4; ++j) {
                const int idx = F.tid + 512 * j, c = idx >> 5, vec = idx & 31;
                const int clo = max(c - half, 0), chi = min(c - half + k, 64);
                f32x4 s0 = {0.f, 0.f, 0.f, 0.f}, s1 = s0;
#pragma unroll 4
                for (int cc = clo; cc < chi; ++cc) { s0 += *(const LAS f32x4*)(vs + cc * 256 + vec * 8); s1 += *(const LAS f32x4*)(vs + cc * 256 + vec * 8 + 4); }
                const float inv = 1.0f / (float)((rhi - rlo) * (chi - clo));
                v4u o; o.x = pk2(s0[0] * inv - bflo(sf[j].x), s0[1] * inv - bfhi(sf[j].x)); o.y = pk2(s0[2] * inv - bflo(sf[j].y), s0[3] * inv - bfhi(sf[j].y));
                o.z = pk2(s1[0] * inv - bflo(sf[j].z), s1[1] * inv - bfhi(sf[j].z)); o.w = pk2(s1[2] * inv - bflo(sf[j].w), s1[3] * inv - bfhi(sf[j].w));
                *(GAS v4u*)(Y + (lofs[j] + (unsigned)r * (unsigned)(64 * D))) = o;
            }
            __syncthreads();
        }
    }
    if (with_ctx) {
        const size_t total = (size_t)NCTX * 256, nthr = (size_t)F.G * NWAVES * 64;
        for (size_t idx = (size_t)F.bid * NWAVES * 64 + F.tid; idx < total; idx += nthr) {
            const int rowc = (int)(idx >> 8), col = (int)(idx & 255) * 8, g = col >> 9, k = 2 << g, half = k >> 1;
            const int b = rowc >> 8, t = rowc & 255, lo = max(t - half, 0), hi = min(t - half + k, CTXL);
            float sum[8];
#pragma unroll
            for (int j = 0; j < 8; ++j) sum[j] = 0.f;
            for (int tt = lo; tt < hi; ++tt) {
                const v4u w = *(const GAS v4u*)(PP + ((size_t)NLAT + b * CTXL + tt) * D + col);
                sum[0] += bflo(w.x); sum[1] += bfhi(w.x); sum[2] += bflo(w.y); sum[3] += bfhi(w.y); sum[4] += bflo(w.z); sum[5] += bfhi(w.z); sum[6] += bflo(w.w); sum[7] += bfhi(w.w);
            }
            const float inv = 1.0f / (float)(hi - lo);
            const size_t off = ((size_t)NLAT + rowc) * D + col;
            const v4u s = *(const GAS v4u*)(PP + off);
            v4u o; o.x = pk2(sum[0] * inv - bflo(s.x), sum[1] * inv - bfhi(s.x)); o.y = pk2(sum[2] * inv - bflo(s.y), sum[3] * inv - bfhi(s.y));
            o.z = pk2(sum[4] * inv - bflo(s.z), sum[5] * inv - bfhi(s.z)); o.w = pk2(sum[6] * inv - bflo(s.w), sum[7] * inv - bfhi(s.w));
            *(GAS v4u*)(Y + off) = o;
        }
    }
}

constexpr unsigned CODE_WARM_BYTES = 200 * 1024;
constexpr int N_PHASES = 31;
__global__ void __launch_bounds__(NWAVES * 64, 2) fwd(Args args) {
    extern __shared__ __attribute__((aligned(16))) unsigned char lds[];
    Frame F;
    F.lds = (LAS unsigned char*)lds;
    F.tid = threadIdx.x; F.lane = F.tid & 63; F.wave = __builtin_amdgcn_readfirstlane(F.tid >> 6);
    F.G = gridDim.x; F.bid = blockIdx.x;
    F.out = (GAS float*)args.out; F.ws = (GAS unsigned char*)args.ws;
    {
        unsigned long long pc_; asm volatile("s_getpc_b64 %0" : "=s"(pc_));
        const unsigned off_ = (unsigned)(((F.bid >> 3) * NWAVES + F.wave) * 1024 + F.lane * 16);
        if (off_ < CODE_WARM_BYTES) { const v4u c_ = *(const GAS v4u*)((pc_ & ~255ull) + off_); asm volatile("" :: "v"(c_)); }
    }
    for (int u = F.tid; u < (LDS_BYTES - LDSCTL_OFF) / 4; u += NWAVES * 64) ((LAS unsigned*)(F.lds + LDSCTL_OFF))[u] = 0u;
    __syncthreads();
    volatile LAS unsigned* MISC = (volatile LAS unsigned*)(F.lds + MISC_OFF);
    XcdBarrier bar; bar.bar = (unsigned*)(args.ws + WS_CTL) + CW_BAR; bar.x = 0; bar.st = nullptr;
    if (!MK_PER_PHASE) bar = xcd_barrier_post((unsigned*)(args.ws + WS_CTL) + CW_BAR, MISC + 8);
    const int lo = args.ph_lo, hi = args.ph_hi;
#ifndef SITE_MASK
#define SITE_MASK 0xFFFF
#endif
#define SITE(i) ((SITE_MASK >> (i)) & 1)
#define IN(k) (lo <= (k) && (k) < hi)
#define SEAM(k, kn) do { if (!MK_PER_PHASE && IN(k) && IN(kn)) xcd_barrier(bar); } while (0)
#define WSP(T, off) ((GAS T*)(F.ws + (off)))
#define MODS_L(L) ((const GAS float*)(F.ws + WS_MODS) + (size_t)(L) * 3 * NMOD)

    if (SITE(0) && IN(0)) { FRESH(F); prologue_phase(F); }
    SEAM(0, 1);
    if (SITE(1) && IN(1)) { FRESH(F); prep_phase(F); }
    SEAM(1, 2);
#define RS_(i) (WSP(unsigned long long, WS_RS) + (size_t)(i) * MR)
#define GS_(L, j) (WSP(const float, WS_GS) + (size_t)((L) * 2 + (j)) * 3 * D)
#define CB_(L, j) (WSP(const float, WS_CB) + (size_t)(L) * 3 * 16384 + ((j) ? 8192 : 0))
    for (int L = 0; L < 4; ++L) {
        const int pb = 2 + 7 * L, e = L >> 1;
        const bool cfull = L < 2;
        if ((L & 1) == 0) {
            if (SITE(2) && IN(pb + 0)) {
                FRESH(F);
                pg8::Gemm g{WSP(bf16, WS_H), WSP(const bf16, WS_WIN) + (size_t)e * INC * D, D, D, D, 0}; pg8::StaticOrder S; S.init((cfull ? MR : NLAT) / 256, INC / 256, F.G, F.bid, WGM_IN);
                pg8::EpiIn E{WSP(bf16, WS_P), WSP(float, WS_G), WSP(const float, WS_LB) + (size_t)e * 2048, WSP(bf16, WS_QH), WSP(bf16, WS_KH), WSP(bf16, WS_VH), RS_(2 * L), CB_(L, 0)};
                pg8::gemm_phase<pg8::EpiIn, true>(F.lds, g, S, E);
                FRESH(F);
                cg::CEpiIn CE{WSP(bf16, WS_P), WSP(float, WS_G), WSP(const float, WS_LB) + (size_t)e * 2048, WSP(bf16, WS_QH), WSP(bf16, WS_KH), WSP(bf16, WS_VH), RS_(2 * L), CB_(L, 0) + 2 * 16384};
                if (!cfull) cg::ctx_gemm<cg::CEpiIn>(F.lds, F.bid, F.G, WSP(const bf16, WS_H) + (size_t)NLAT * D, D, WSP(const bf16, WS_WIN) + (size_t)e * INC * D, D, 1024, 4096, D, 0, NLAT, CE);
            }
            SEAM(pb + 0, pb + 1);
            if (SITE(3) && IN(pb + 1)) {
                if ((F.bid >> 3) & 1) { FRESH(F); spatial_mfma_phase(F, e, cfull ? 132 : 128); FRESH(F); scan_fast_phase<true>(F); }
                else { FRESH(F); scan_fast_phase<true>(F); FRESH(F); spatial_mfma_phase(F, e, cfull ? 132 : 128); }
            }
            SEAM(pb + 1, pb + 2);
            if (SITE(13) && IN(pb + 2)) { FRESH(F); scan_fast_phase<false>(F); }
            SEAM(pb + 2, pb + 3);
            if (SITE(4) && IN(pb + 3)) { FRESH(F); readout_phase(F, e, cfull ? MR : NLAT); }
            SEAM(pb + 3, pb + 4);
            if (SITE(5) && IN(pb + 4)) {
                FRESH(F);
                pg8::Gemm g{WSP(bf16, WS_Y), WSP(const bf16, WS_WOUT) + (size_t)e * D * D, D, D, D, 0}; pg8::StaticOrder S; S.init(NLAT / 256, D / 256, F.G, F.bid, WGM_OUT);
                pg8::EpiRes E{WSP(bf16, WS_X), in_ptr(0), L == 0, MODS_L(L) + 4096, NMOD, nullptr, nullptr, WSP(bf16, WS_H), GS_(L, 1), RS_(2 * L + 1), nullptr};
                pg8::gemm_phase<pg8::EpiRes, true>(F.lds, g, S, E);
                if (cfull) {
                    FRESH(F);
                    cg::CEpiRes CE{WSP(bf16, WS_X), in_ptr(2) - (size_t)NLAT * D, L == 0, MODS_L(L) + 2 * NMOD + 4096, nullptr, nullptr, WSP(bf16, WS_H), GS_(L, 1) + 2 * D, RS_(2 * L + 1)};
                    cg::ctx_gemm<cg::CEpiRes>(F.lds, F.bid, F.G, WSP(const bf16, WS_Y) + (size_t)NLAT * D, D, WSP(const bf16, WS_WOUT) + (size_t)e * D * D, D, 0, D, D, 0, NLAT, CE);
                }
            }
        } else {
            if (SITE(6) && IN(pb + 0)) {
                FRESH(F);
                pg8::Gemm g{WSP(bf16, WS_H), WSP(const bf16, WS_WP) + (size_t)e * D * D, D, D, D, 0}; pg8::StaticOrder S; S.init(NLAT / 256, D / 256, F.G, F.bid, WGM_PIN);
                pg8::EpiAct<0> E{WSP(bf16, WS_P), D, RS_(2 * L), CB_(L, 0)};
                pg8::gemm_phase<pg8::EpiAct<0>, true>(F.lds, g, S, E);
                if (cfull) {
                    FRESH(F);
                    cg::CEpiAct<0> CE{WSP(bf16, WS_P), D, RS_(2 * L), CB_(L, 0) + 2 * 16384};
                    cg::ctx_gemm<cg::CEpiAct<0>>(F.lds, F.bid, F.G, WSP(const bf16, WS_H) + (size_t)NLAT * D, D, WSP(const bf16, WS_WP) + (size_t)e * D * D, D, 0, D, D, 0, NLAT, CE);
                }
            }
            SEAM(pb + 0, pb + 1);
            if (SITE(7) && IN(pb + 1)) { FRESH(F); pool_fast_phase(F, cfull); }
            SEAM(pb + 1, pb + 4);
            if (SITE(8) && IN(pb + 4)) {
                FRESH(F);
                pg8::Gemm g{WSP(bf16, WS_Y), WSP(const bf16, WS_WG) + (size_t)e * D * 512, D, 512, 512, 512}; pg8::StaticOrder S; S.init(NLAT / 256, D / 256, F.G, F.bid, WGM_GRP);
                pg8::EpiRes E{WSP(bf16, WS_X), nullptr, false, MODS_L(L) + 4096, NMOD, in_ptr(17) + (size_t)e * D, in_ptr(18) + (size_t)e * D, WSP(bf16, WS_H), GS_(L, 1), RS_(2 * L + 1), nullptr};
                pg8::gemm_phase<pg8::EpiRes, true>(F.lds, g, S, E);
                if (cfull) {
                    FRESH(F);
                    cg::CEpiRes CE{WSP(bf16, WS_X), nullptr, false, MODS_L(L) + 2 * NMOD + 4096, in_ptr(17) + (size_t)e * D, in_ptr(18) + (size_t)e * D, WSP(bf16, WS_H), GS_(L, 1) + 2 * D, RS_(2 * L + 1)};
                    cg::ctx_gemm<cg::CEpiRes>(F.lds, F.bid, F.G, WSP(const bf16, WS_Y) + (size_t)NLAT * D, D, WSP(const bf16, WS_WG) + (size_t)e * D * 512, 512, 0, D, 512, 512, NLAT, CE);
                }
            }
        }
        SEAM(pb + 4, pb + 5);
        if (SITE(10) && IN(pb + 5)) {
            FRESH(F);
            pg8::Gemm g{WSP(bf16, WS_H), WSP(const bf16, WS_WUP) + (size_t)L * DFF * D, D, D, D, 0}; pg8::StaticOrder S; S.init((cfull ? MR : NLAT) / 256, DFF / 256, F.G, F.bid, WGM_UP);
            pg8::EpiAct<1> E{WSP(bf16, WS_HID), DFF, RS_(2 * L + 1), CB_(L, 1)};
            pg8::gemm_phase<pg8::EpiAct<1>, true>(F.lds, g, S, E);
        }
        SEAM(pb + 5, pb + 6);
        if (SITE(11) && IN(pb + 6)) {
            FRESH(F);
            pg8::Gemm g{WSP(bf16, WS_HID), WSP(const bf16, WS_WDN) + (size_t)L * D * DFF, DFF, DFF, DFF, 0}; pg8::StaticOrder S; S.init(NLAT / 256, D / 256, F.G, F.bid, WGM_DN);
            pg8::EpiRes E{WSP(bf16, WS_X), nullptr, false, MODS_L(L) + 10240, NMOD, nullptr, nullptr, L < 3 ? WSP(bf16, WS_H) : (GAS bf16*)nullptr, GS_(L + 1, 0), RS_(2 * L + 2), L == 3 ? F.out : (GAS float*)nullptr};
            pg8::gemm_phase<pg8::EpiRes, true>(F.lds, g, S, E);
            if (cfull) {
                FRESH(F);
                cg::CEpiRes CE{WSP(bf16, WS_X), nullptr, false, MODS_L(L) + 2 * NMOD + 10240, nullptr, nullptr, WSP(bf16, WS_H), GS_(L + 1, 0) + 2 * D, RS_(2 * L + 2)};
                cg::ctx_gemm<cg::CEpiRes>(F.lds, F.bid, F.G, WSP(const bf16, WS_HID) + (size_t)NLAT * DFF, DFF, WSP(const bf16, WS_WDN) + (size_t)L * D * DFF, DFF, 0, D, DFF, 0, NLAT, CE);
            }
        }
        SEAM(pb + 6, pb + 7);
    }
    if (SITE(12) && IN(30)) { FRESH(F); final_norm_phase(F); }
#undef IN
#undef SEAM
}

extern "C" void kernel_launch(void* const* d_in, const int* in_sizes, int n_in, void* d_out, int out_size, void* d_ws, size_t ws_size, hipStream_t stream) {
    static int grid = 0;
    if (grid == 0) {
        if (n_in != 22 || in_sizes[0] != NLAT * D || out_size != NLAT * D || ws_size < WS_END) {
            fprintf(stderr, "kernel_launch: unexpected shapes (n_in %d, in0 %d, out %d, ws %zu, need %zu); nothing launched\n", n_in, n_in > 0 ? in_sizes[0] : -1, out_size, ws_size, (size_t)WS_END); grid = -1; return; }
        int dev = 0, cus = 0, per_cu = 0;
        if (hipGetDevice(&dev) != hipSuccess || hipDeviceGetAttribute(&cus, hipDeviceAttributeMultiprocessorCount, dev) != hipSuccess) { fprintf(stderr, "kernel_launch: device query failed\n"); grid = -1; return; }
        if (hipFuncSetAttribute((const void*)fwd, hipFuncAttributeMaxDynamicSharedMemorySize, LDS_BYTES) != hipSuccess) { fprintf(stderr, "kernel_launch: hipFuncSetAttribute failed\n"); grid = -1; return; }
        if (hipOccupancyMaxActiveBlocksPerMultiprocessor(&per_cu, (const void*)fwd, NWAVES * 64, LDS_BYTES) != hipSuccess || per_cu < 1)
            fprintf(stderr, "kernel_launch: note: occupancy query reports %d workgroups per CU\n", per_cu);
        (void)hipGetLastError();
        grid = cus;
    }
    if (grid < 0) return;
    if (hipMemsetAsync((char*)d_ws + WS_CTL, 0, CTL_ZERO_BYTES, stream) != hipSuccess) { fprintf(stderr, "kernel_launch: memset failed\n"); return; }
    Args a{};
    for (int i = 0; i < 22; ++i) a.in[i] = (const float*)d_in[i];
    a.out = (float*)d_out; a.ws = (unsigned char*)d_ws;
#if MK_PER_PHASE
    for (int ph = 0; ph < N_PHASES; ++ph) {
        if (ph >= 2 && ph <= 29) { const int L = (ph - 2) / 7, s = (ph - 2) % 7; if ((L & 1) && (s == 2 || s == 3)) continue; }
        a.ph_lo = ph; a.ph_hi = ph + 1;
        hipLaunchKernelGGL(fwd, dim3(grid), dim3(NWAVES * 64), LDS_BYTES, stream, a);
    }
#else
    a.ph_lo = 0; a.ph_hi = N_PHASES;
    hipLaunchKernelGGL(fwd, dim3(grid), dim3(NWAVES * 64), LDS_BYTES, stream, a);
#endif
    const hipError_t le = hipPeekAtLastError();
    if (le != hipSuccess) fprintf(stderr, "kernel_launch: launch failed: %s\n", hipGetErrorName(le));
}
```

```cpp
#include <hip/hip_runtime.h>
#include <cstdio>
#include <cstdint>

#ifndef WGM_IN
#define WGM_IN 4
#endif
#ifndef WGM_OUT
#define WGM_OUT 4
#endif
#ifndef WGM_PIN
#define WGM_PIN 4
#endif
#ifndef WGM_GRP
#define WGM_GRP 4
#endif
#ifndef WGM_UP
#define WGM_UP 4
#endif
#ifndef WGM_DN
#define WGM_DN 4
#endif
#ifndef MK_PER_PHASE
#define MK_PER_PHASE 0
#endif

namespace pg8 {
#define PG8_LAS __attribute__((address_space(3)))
#define GAS __attribute__((address_space(1)))
typedef unsigned short bf16_t;
typedef short bf16x8 __attribute__((ext_vector_type(8)));
typedef float f32x4 __attribute__((ext_vector_type(4)));
typedef float f32x2 __attribute__((ext_vector_type(2)));
typedef unsigned u32x4 __attribute__((ext_vector_type(4)));
typedef unsigned u32x2 __attribute__((ext_vector_type(2)));
constexpr int BM = 256, BK = 64, HALF = 128, HTB = HALF * BK * 2, STAGE_BYTES = 8 * HTB, NXCD = 8;

__host__ __device__ __forceinline__ int lds_byte(int r, int c) { const int st = (r >> 4) * 2 + (c >> 5), rr = r & 15, cc = c & 31, ob = rr * 64 + cc * 2; return st * 1024 + (ob ^ (((ob >> 9) & 1) << 5)); }
__host__ __device__ __forceinline__ void stage_rc(int b, int& R, int& C) { const int st = b / 1024, sb = b % 1024, swz = sb ^ (((sb >> 9) & 1) << 5); R = (st >> 1) * 16 + swz / 64; C = (st & 1) * 32 + (swz % 64) / 2; }
__host__ __device__ __forceinline__ int perm32(int rho) { const int n = rho >> 4, i = rho & 15; return 8 * (i >> 2) + 4 * n + (i & 3); }

struct Unit { int pm, pn; };
struct Gemm { const GAS bf16_t* A; const GAS bf16_t* Bt; int lda, ldb, K, agrp; };

struct StaticOrder {
    int nM, nN, nwg, G, c, WGM;
    __host__ __device__ void init(int nM_, int nN_, int G_, int c_, int wgm_) { nM = nM_; nN = nN_; nwg = nM * nN; G = G_; c = c_; WGM = wgm_; }
    __host__ __device__ bool next(int i, Unit& u) const {
        const long L = (long)i * G + c; if (L >= nwg) return false;
        int wgid = (int)L; { const int q = nwg / NXCD, r = nwg % NXCD, xcd = wgid % NXCD, off = wgid / NXCD; wgid = (xcd < r ? xcd * (q + 1) : r * (q + 1) + (xcd - r) * q) + off; }
        const int nig = WGM * nN, gid = wgid / nig, fm = gid * WGM, gsz = (nM - fm) < WGM ? (nM - fm) : WGM;
        u.pm = fm + ((wgid % nig) % gsz); u.pn = (wgid % nig) / gsz; return true;
    }
};

__device__ __forceinline__ unsigned cvt_pk_bf16(float lo, float hi) { unsigned r; asm volatile("v_cvt_pk_bf16_f32 %0, %1, %2" : "=v"(r) : "v"(lo), "v"(hi)); return r; }
__device__ __forceinline__ f32x2 gelu_pk(f32x2 v) {
    const f32x2 av = __builtin_elementwise_abs(v), d = av * 0.2316418882f + 1.0f;
    f32x2 t; t.x = __builtin_amdgcn_rcpf(d.x); t.y = __builtin_amdgcn_rcpf(d.y);
    f32x2 q = t * 0.5307027145f + (-0.7265760135f); q = q * t + 0.7107068705f; q = q * t + (-0.142248368f); q = q * t + 0.127414796f; q = q * t;
    const f32x2 s = (v * v) * (-0.72134752044f);
    f32x2 e; e.x = __builtin_amdgcn_exp2f(s.x); e.y = __builtin_amdgcn_exp2f(s.y);
    const f32x2 m = v * (q * e), r = v - m;
    f32x2 o; o.x = v.x < 0.f ? m.x : r.x; o.y = v.y < 0.f ? m.y : r.y; return o;
}
__device__ __forceinline__ f32x4 gelu4(f32x4 v) { const f32x2 a = gelu_pk((f32x2){v[0], v[1]}), b = gelu_pk((f32x2){v[2], v[3]}); return (f32x4){a.x, a.y, b.x, b.y}; }
__device__ __forceinline__ float sigmoidf_(float x) { return __builtin_amdgcn_rcpf(1.0f + __expf(-x)); }

__device__ __forceinline__ size_t hm_off(int r, int h) { return r < 16384 ? ((size_t)(((r >> 13) * 8 + h) * 8192 + (r & 8191))) * 128 : (size_t)16 * 8192 * 128 + ((size_t)((((r - 16384) >> 8) * 8 + h) * 256 + ((r - 16384) & 255))) * 128; }
constexpr size_t HM_ELEMS = (size_t)16 * (8192 + 256) * 128;
struct EpiIn {
    static constexpr bool PERM = true;
    GAS bf16_t* P; GAS float* Gl; const GAS float* lb;
    GAS bf16_t* QH; GAS bf16_t* KH; GAS bf16_t* VH;
    const GAS unsigned long long* rs; const GAS float* cb;
    __device__ __forceinline__ void operator()(const f32x4 (&acc)[2][2][4][2], const Unit& u, int wr, int wc, int fr, int fq) const {
        const int seg = u.pn >> 2;
        const int row0 = u.pm * BM + wr * 64 + fr, col0 = u.pn * BM + wc * 32 + 8 * fq;
        const GAS float* cbr = cb + (size_t)(u.pm < 32 ? 0 : (u.pm < 64 ? 1 : 2)) * 16384;
        if (seg == 1 || seg == 2) {
#pragma unroll
            for (int bj = 0; bj < 2; ++bj) {
                const int c = col0 + bj * HALF;
                const f32x4 l0 = *(const GAS f32x4*)(lb + c - 1024), l1 = *(const GAS f32x4*)(lb + c - 1024 + 4);
                const f32x4 c0 = *(const GAS f32x4*)(cbr + c), c1 = *(const GAS f32x4*)(cbr + c + 4);
#pragma unroll
                for (int ai = 0; ai < 2; ++ai)
#pragma unroll
                    for (int m = 0; m < 4; ++m) {
                        const size_t row = (size_t)(row0 + ai * HALF + m * 16);
                        const float rstd = rsqrtf((float)rs[row] * (1.0f / (2048.0f * 1048576.0f)) + 1e-6f);
                        f32x4 g0, g1;
#pragma unroll
                        for (int j = 0; j < 4; ++j) {
                            { const float f = fminf(fmaxf(acc[ai][bj][m][0][j] * rstd + c0[j], -60.f), 60.f), e = __expf(-f), sg = __builtin_amdgcn_rcpf(1.0f + e), l = l0[j];
                              g0[j] = __logf(fmaxf(l + (1.0f - l) * sg, 1e-30f)); }
                            { const float f = fminf(fmaxf(acc[ai][bj][m][1][j] * rstd + c1[j], -60.f), 60.f), e = __expf(-f), sg = __builtin_amdgcn_rcpf(1.0f + e), l = l1[j];
                              g1[j] = __logf(fmaxf(l + (1.0f - l) * sg, 1e-30f)); }
                        }
                        const size_t ho = (size_t)(seg - 1) * HM_ELEMS + hm_off((int)row, (c >> 7) & 7) + (c & 127);
                        *(GAS f32x4*)(Gl + ho) = g0; *(GAS f32x4*)(Gl + ho + 4) = g1;
                    }
            }
        } else {
            const int mode = (seg == 4) ? 1 : (seg >= 5 ? 2 : 0);
#pragma unroll
            for (int ai = 0; ai < 2; ++ai)
#pragma unroll
                for (int m = 0; m < 4; ++m) {
                    const size_t row = (size_t)(row0 + ai * HALF + m * 16);
                    const float rstd = rsqrtf((float)rs[row] * (1.0f / (2048.0f * 1048576.0f)) + 1e-6f);
#pragma unroll
                    for (int bj = 0; bj < 2; ++bj) {
                        f32x4 v0 = acc[ai][bj][m][0] * rstd + *(const GAS f32x4*)(cbr + col0 + bj * HALF), v1 = acc[ai][bj][m][1] * rstd + *(const GAS f32x4*)(cbr + col0 + bj * HALF + 4);
                        if (mode == 1) {
#pragma unroll
                            for (int j = 0; j < 4; ++j) { v0[j] = v0[j] * sigmoidf_(v0[j]); v1[j] = v1[j] * sigmoidf_(v1[j]); }
                        } else if (mode == 2) { v0 = gelu4(v0); v1 = gelu4(v1); }
                        u32x4 w; w.x = cvt_pk_bf16(v0[0], v0[1]); w.y = cvt_pk_bf16(v0[2], v0[3]); w.z = cvt_pk_bf16(v1[0], v1[1]); w.w = cvt_pk_bf16(v1[2], v1[3]);
                        const int c = col0 + bj * HALF;
                        if (seg == 0 || seg == 3) *(GAS u32x4*)((seg == 0 ? QH : VH) + hm_off((int)row, (c >> 7) & 7) + (c & 127)) = w;
                        else *(GAS u32x4*)(P + row * 7168 + c) = w;
                    }
                }
        }
    }
};
template <int ACT> struct EpiAct {
    static constexpr bool PERM = true;
    GAS bf16_t* O; int ldc; const GAS unsigned long long* rs; const GAS float* cb;
    __device__ __forceinline__ void operator()(const f32x4 (&acc)[2][2][4][2], const Unit& u, int wr, int wc, int fr, int fq) const {
        const int row0 = u.pm * BM + wr * 64 + fr, col0 = u.pn * BM + wc * 32 + 8 * fq;
        const GAS float* cbr = cb + (size_t)(u.pm < 32 ? 0 : (u.pm < 64 ? 1 : 2)) * 16384 + col0;
        const f32x4 cb00 = *(const GAS f32x4*)(cbr), cb01 = *(const GAS f32x4*)(cbr + 4), cb10 = *(const GAS f32x4*)(cbr + HALF), cb11 = *(const GAS f32x4*)(cbr + HALF + 4);
#pragma unroll
        for (int ai = 0; ai < 2; ++ai)
#pragma unroll
            for (int m = 0; m < 4; ++m) {
                GAS bf16_t* rowp = O + (size_t)(row0 + ai * HALF + m * 16) * ldc + col0;
                const float rstd = rsqrtf((float)rs[row0 + ai * HALF + m * 16] * (1.0f / (2048.0f * 1048576.0f)) + 1e-6f);
#pragma unroll
                for (int bj = 0; bj < 2; ++bj) {
                    f32x4 v0 = acc[ai][bj][m][0] * rstd + (bj ? cb10 : cb00), v1 = acc[ai][bj][m][1] * rstd + (bj ? cb11 : cb01);
                    if (ACT == 1) {
#pragma unroll
                        for (int j = 0; j < 4; ++j) { const float a = fmaxf(v0[j], 0.f), b = fmaxf(v1[j], 0.f); v0[j] = a * a; v1[j] = b * b; }
                    }
                    u32x4 w; w.x = cvt_pk_bf16(v0[0], v0[1]); w.y = cvt_pk_bf16(v0[2], v0[3]); w.z = cvt_pk_bf16(v1[0], v1[1]); w.w = cvt_pk_bf16(v1[2], v1[3]);
                    *(GAS u32x4*)(rowp + bj * HALF) = w;
                }
            }
    }
};
__device__ __forceinline__ f32x4 bf4lo(u32x4 w) { return (f32x4){__builtin_bit_cast(float, w.x << 16), __builtin_bit_cast(float, w.x & 0xffff0000u), __builtin_bit_cast(float, w.y << 16), __builtin_bit_cast(float, w.y & 0xffff0000u)}; }
__device__ __forceinline__ f32x4 bf4hi(u32x4 w) { return (f32x4){__builtin_bit_cast(float, w.z << 16), __builtin_bit_cast(float, w.z & 0xffff0000u), __builtin_bit_cast(float, w.w << 16), __builtin_bit_cast(float, w.w & 0xffff0000u)}; }
struct EpiRes {
    static constexpr bool PERM = true;
    GAS bf16_t* X; const GAS float* Xin; bool xf32;
    const GAS float* gate; int gstride; const GAS float* bias; const GAS float* scale;
    GAS bf16_t* Hn; const GAS float* gsn; GAS unsigned long long* rsn;
    GAS float* Xout32;
    __device__ __forceinline__ void operator()(const f32x4 (&acc)[2][2][4][2], const Unit& u, int wr, int wc, int fr, int fq) const {
        const int mr = u.pm < 32 ? 0 : (u.pm < 64 ? 1 : 2);
        const GAS float* gt = gate + (size_t)mr * gstride;
        const int row0 = u.pm * BM + wr * 64 + fr, col0 = u.pn * BM + wc * 32 + 8 * fq;
        f32x4 ga[2][2], gs[2][2];
#pragma unroll
        for (int bj = 0; bj < 2; ++bj)
#pragma unroll
            for (int n = 0; n < 2; ++n) {
                const int c = col0 + bj * HALF + 4 * n;
                gs[bj][n] = Hn ? *(const GAS f32x4*)(gsn + (size_t)mr * 2048 + c) : (f32x4){0.f, 0.f, 0.f, 0.f};
                ga[bj][n] = *(const GAS f32x4*)(gt + c);
                if (scale) ga[bj][n] = ga[bj][n] * *(const GAS f32x4*)(scale + c);
            }
#pragma unroll
        for (int ai = 0; ai < 2; ++ai)
#pragma unroll
        for (int mp = 0; mp < 4; mp += 2) {
            u32x4 raw[2][2][2];
#pragma unroll
            for (int m2 = 0; m2 < 2; ++m2)
#pragma unroll
                for (int bj = 0; bj < 2; ++bj) {
                    const size_t o = (size_t)(row0 + ai * HALF + (mp + m2) * 16) * 2048 + col0 + bj * HALF;
                    if (xf32) { raw[m2][bj][0] = *(const GAS u32x4*)(Xin + o); raw[m2][bj][1] = *(const GAS u32x4*)(Xin + o + 4); }
                    else { raw[m2][bj][0] = *(const GAS u32x4*)(X + o); raw[m2][bj][1] = raw[m2][bj][0]; }
                }
            asm volatile("" ::: "memory");
#pragma unroll
            for (int m2 = 0; m2 < 2; ++m2) {
                const int m = mp + m2;
                const size_t row = (size_t)(row0 + ai * HALF + m * 16);
                float ss = 0.f;
#pragma unroll
                for (int bj = 0; bj < 2; ++bj) {
                    const f32x4 xi0 = xf32 ? __builtin_bit_cast(f32x4, raw[m2][bj][0]) : bf4lo(raw[m2][bj][0]), xi1 = xf32 ? __builtin_bit_cast(f32x4, raw[m2][bj][1]) : bf4hi(raw[m2][bj][0]);
                    f32x4 a0 = acc[ai][bj][m][0], a1 = acc[ai][bj][m][1];
                    if (bias) { a0 += *(const GAS f32x4*)(bias + col0 + bj * HALF); a1 += *(const GAS f32x4*)(bias + col0 + bj * HALF + 4); }
                    const f32x4 x0 = xi0 + ga[bj][0] * a0, x1 = xi1 + ga[bj][1] * a1;
                    const size_t o = row * 2048 + col0 + bj * HALF;
                    if (Xout32) { *(GAS f32x4*)(Xout32 + o) = x0; *(GAS f32x4*)(Xout32 + o + 4) = x1; }
                    else *(GAS u32x4*)(X + o) = (u32x4){cvt_pk_bf16(x0[0], x0[1]), cvt_pk_bf16(x0[2], x0[3]), cvt_pk_bf16(x1[0], x1[1]), cvt_pk_bf16(x1[2], x1[3])};
                    if (Hn) { const f32x4 h0 = x0 * gs[bj][0], h1 = x1 * gs[bj][1];
                        ss += ((x0[0] * x0[0] + x0[1] * x0[1]) + (x0[2] * x0[2] + x0[3] * x0[3])) + ((x1[0] * x1[0] + x1[1] * x1[1]) + (x1[2] * x1[2] + x1[3] * x1[3]));
                        *(GAS u32x4*)(Hn + o) = (u32x4){cvt_pk_bf16(h0[0], h0[1]), cvt_pk_bf16(h0[2], h0[3]), cvt_pk_bf16(h1[0], h1[1]), cvt_pk_bf16(h1[2], h1[3])}; }
                }
                if (Hn) { ss += __shfl_xor(ss, 16); ss += __shfl_xor(ss, 32); if (fq == 0) __hip_atomic_fetch_add(rsn + row, (unsigned long long)(ss * 1048576.0f), __ATOMIC_RELAXED, __HIP_MEMORY_SCOPE_AGENT); }
            }
            asm volatile("" ::: "memory");
        }
    }
};

template <class Epi, bool ALIGN_EPI>
__device__ __forceinline__ void gemm_phase(PG8_LAS unsigned char* lds, const Gemm g, const StaticOrder& S, const Epi& E) {
    int tid_ = threadIdx.x; asm volatile("" : "+v"(tid_));
    const int tid = tid_, wid = __builtin_amdgcn_readfirstlane(tid >> 6), lane = tid & 63, wr = wid >> 2, wc = wid & 3, fr = lane & 15, fq = lane >> 4;
    const int K = g.K, nt = K / BK;
    unsigned voffA[2], voffB[2];
#pragma unroll
    for (int i = 0; i < 2; ++i) { int R, C; stage_rc(tid * 16 + i * 8192, R, C); const int Rb = Epi::PERM ? ((R & ~31) + perm32(R & 31)) : R;
        voffA[i] = (unsigned)(R * g.lda + C) * 2u; voffB[i] = (unsigned)(Rb * g.ldb + C) * 2u; }
    const size_t kstep = (size_t)(BK * 2);
    const size_t hstepA = (size_t)HALF * g.lda * 2, hstepB = (size_t)HALF * g.ldb * 2;
    const unsigned ldsw = (unsigned)wid * 1024u;
    const int aoff = lds_byte(wr * 64 + fr, fq * 8), boff = lds_byte(wc * 32 + fr, fq * 8);
#define PG8_UA(u) ((const GAS char*)g.A + (size_t)(u).pm * 2 * hstepA + (g.agrp ? (size_t)((((u).pn * BM) / g.agrp) * g.agrp) * 2 : (size_t)0))
#define PG8_UB(u) ((const GAS char*)g.Bt + (size_t)(u).pn * 2 * hstepB)
#define PG8_SA(b, h) (((b) * 2 + (h)) * HTB)
#define PG8_SB(b, h) ((4 + (b) * 2 + (h)) * HTB)
#define PG8_STAGE(bufoff, gbase, voff) do { _Pragma("unroll") for (int _i = 0; _i < 2; ++_i) \
        __builtin_amdgcn_global_load_lds((const GAS unsigned*)((const GAS char*)(gbase) + (voff)[_i]), (PG8_LAS unsigned*)(lds + (bufoff) + ldsw + _i * 8192), 16, 0, 0); } while (0)
#define PG8_LDA(dst, b, h) do { _Pragma("unroll") for (int m = 0; m < 4; ++m) _Pragma("unroll") for (int k = 0; k < 2; ++k) dst[m][k] = *(const PG8_LAS bf16x8*)(lds + PG8_SA(b, h) + aoff + m * 2048 + k * 1024); } while (0)
#define PG8_LDB(dst, b, h) do { _Pragma("unroll") for (int n = 0; n < 2; ++n) _Pragma("unroll") for (int k = 0; k < 2; ++k) dst[n][k] = *(const PG8_LAS bf16x8*)(lds + PG8_SB(b, h) + boff + n * 2048 + k * 1024); } while (0)
#define PG8_MMA(ai, bj, At, Bt) do { __builtin_amdgcn_s_setprio(1); _Pragma("unroll") for (int m = 0; m < 4; ++m) _Pragma("unroll") for (int n = 0; n < 2; ++n) _Pragma("unroll") for (int k = 0; k < 2; ++k) \
        acc[ai][bj][m][n] = __builtin_amdgcn_mfma_f32_16x16x32_bf16(Bt[n][k], At[m][k], acc[ai][bj][m][n], 0, 0, 0); __builtin_amdgcn_s_setprio(0); } while (0)
#define PG8_WAIT_V(n) asm volatile("s_waitcnt vmcnt(" #n ")" ::: "memory")
#define PG8_WAIT_L(n) asm volatile("s_waitcnt lgkmcnt(" #n ")" ::: "memory")
#define PG8_BAR __builtin_amdgcn_s_barrier()
#define PG8_SCHED __builtin_amdgcn_sched_barrier(0)
    Unit cur, nxt; int ui = 0;
    if (!S.next(0, cur)) return;
    f32x4 acc[2][2][4][2];
#pragma unroll
    for (int a = 0; a < 2; ++a)
#pragma unroll
        for (int b = 0; b < 2; ++b)
#pragma unroll
            for (int m = 0; m < 4; ++m)
#pragma unroll
                for (int n = 0; n < 2; ++n) acc[a][b][m][n] = (f32x4){0.f, 0.f, 0.f, 0.f};
    bf16x8 At[4][2], B0[2][2], B1[2][2];
    const GAS char* cA = PG8_UA(cur); const GAS char* cB = PG8_UB(cur);
    PG8_STAGE(PG8_SB(0, 0), cB, voffB); PG8_STAGE(PG8_SB(0, 1), cB + hstepB, voffB); PG8_STAGE(PG8_SA(0, 0), cA, voffA); PG8_STAGE(PG8_SA(0, 1), cA + hstepA, voffA);
    if (wr == 1) PG8_BAR;
    PG8_WAIT_V(2); PG8_BAR;
    PG8_STAGE(PG8_SB(1, 0), cB + kstep, voffB); PG8_STAGE(PG8_SA(1, 0), cA + kstep, voffA); PG8_STAGE(PG8_SB(1, 1), cB + hstepB + kstep, voffB);
    PG8_WAIT_V(6); PG8_BAR;
    for (;;) {
        const bool has_next = S.next(ui + 1, nxt);
        const GAS char* nA = has_next ? PG8_UA(nxt) : cA; const GAS char* nB = has_next ? PG8_UB(nxt) : cB;
        for (int t = 0; t < nt; t += 2) {
            const bool last = (t == nt - 2);
            const GAS char* a1 = cA + (size_t)(t + 1) * kstep;
            const GAS char* a2 = last ? nA : cA + (size_t)(t + 2) * kstep; const GAS char* b2 = last ? nB : cB + (size_t)(t + 2) * kstep;
            const GAS char* a3 = a2 + kstep; const GAS char* b3 = b2 + kstep;
            PG8_LDB(B0, 0, 0); PG8_LDB(B1, 0, 1); PG8_SCHED; PG8_LDA(At, 0, 0); PG8_STAGE(PG8_SA(1, 1), a1 + hstepA, voffA);
            PG8_WAIT_V(8); PG8_WAIT_L(0); PG8_BAR; PG8_MMA(0, 0, At, B0); PG8_MMA(0, 1, At, B1); PG8_BAR; PG8_SCHED;
            PG8_LDA(At, 0, 1); PG8_STAGE(PG8_SB(0, 0), b2, voffB); PG8_STAGE(PG8_SB(0, 1), b2 + hstepB, voffB); PG8_STAGE(PG8_SA(0, 0), a2, voffA);
            PG8_WAIT_V(8); PG8_WAIT_L(0); PG8_BAR; PG8_MMA(1, 0, At, B0); PG8_MMA(1, 1, At, B1); PG8_BAR; PG8_SCHED;
            PG8_LDB(B0, 1, 0); PG8_LDB(B1, 1, 1); PG8_SCHED; PG8_LDA(At, 1, 0); PG8_STAGE(PG8_SA(0, 1), a2 + hstepA, voffA);
            PG8_WAIT_V(8); PG8_WAIT_L(0); PG8_BAR; PG8_MMA(0, 0, At, B0); PG8_MMA(0, 1, At, B1); PG8_BAR; PG8_SCHED;
            PG8_LDA(At, 1, 1); PG8_STAGE(PG8_SB(1, 0), b3, voffB); PG8_STAGE(PG8_SB(1, 1), b3 + hstepB, voffB); PG8_STAGE(PG8_SA(1, 0), a3, voffA);
            PG8_WAIT_V(8); PG8_WAIT_L(0); PG8_BAR; PG8_MMA(1, 0, At, B0); PG8_MMA(1, 1, At, B1); PG8_BAR; PG8_SCHED;
        }
        if constexpr (ALIGN_EPI) { if (wr == 0) PG8_BAR; }
        E(acc, cur, wr, wc, fr, fq);
        if (!has_next) break;
#pragma unroll
        for (int a = 0; a < 2; ++a)
#pragma unroll
            for (int b = 0; b < 2; ++b)
#pragma unroll
                for (int m = 0; m < 4; ++m)
#pragma unroll
                    for (int n = 0; n < 2; ++n) acc[a][b][m][n] = (f32x4){0.f, 0.f, 0.f, 0.f};
        cur = nxt; cA = nA; cB = nB; ++ui;
        if constexpr (ALIGN_EPI) { if (wr == 1) PG8_BAR; }
    }
    PG8_WAIT_V(0);
    if constexpr (!ALIGN_EPI) { if (wr == 0) PG8_BAR; }
    PG8_BAR;
#undef PG8_UA
#undef PG8_UB
#undef PG8_SA
#undef PG8_SB
#undef PG8_STAGE
#undef PG8_LDA
#undef PG8_LDB
#undef PG8_MMA
#undef PG8_WAIT_V
#undef PG8_WAIT_L
#undef PG8_BAR
#undef PG8_SCHED
}
}


namespace cg {
using pg8::f32x4; using pg8::bf16x8; using pg8::bf16_t; using pg8::cvt_pk_bf16;
using pg8::u32x2;
struct CEpiIn {
    GAS bf16_t* P; GAS float* Gl; const GAS float* lb; GAS bf16_t* QH; GAS bf16_t* KH; GAS bf16_t* VH; const GAS unsigned long long* rs; const GAS float* cb;
    __device__ __forceinline__ void apply(int row, int col, f32x4 v) const {
        const int seg = col >> 10;
        v = v * rsqrtf((float)rs[row] * (1.0f / (2048.0f * 1048576.0f)) + 1e-6f) + *(const GAS f32x4*)(cb + col);
        if (seg == 1 || seg == 2) {
            const f32x4 l4 = *(const GAS f32x4*)(lb + col - 1024); f32x4 g4;
#pragma unroll
            for (int j = 0; j < 4; ++j) { const float f = fminf(fmaxf(v[j], -60.f), 60.f), e = __expf(-f), sg = __builtin_amdgcn_rcpf(1.0f + e), l = l4[j];
                g4[j] = __logf(fmaxf(l + (1.0f - l) * sg, 1e-30f)); }
            const size_t ho = (size_t)(seg - 1) * pg8::HM_ELEMS + pg8::hm_off(row, (col >> 7) & 7) + (col & 127);
            *(GAS f32x4*)(Gl + ho) = g4;
        } else {
            if (seg == 4) {
#pragma unroll
                for (int j = 0; j < 4; ++j) v[j] = v[j] * pg8::sigmoidf_(v[j]);
            } else if (seg >= 5) v = pg8::gelu4(v);
            const u32x2 wv = (u32x2){cvt_pk_bf16(v[0], v[1]), cvt_pk_bf16(v[2], v[3])};
            if (seg == 0 || seg == 3) *(GAS u32x2*)((seg == 0 ? QH : VH) + pg8::hm_off(row, (col >> 7) & 7) + (col & 127)) = wv;
            else *(GAS u32x2*)(P + (size_t)row * 7168 + col) = wv;
        }
    }
};
template <int ACT> struct CEpiAct {
    GAS bf16_t* O; int ldc; const GAS unsigned long long* rs; const GAS float* cb;
    __device__ __forceinline__ void apply(int row, int col, f32x4 v) const {
        v = v * rsqrtf((float)rs[row] * (1.0f / (2048.0f * 1048576.0f)) + 1e-6f) + *(const GAS f32x4*)(cb + col);
        if (ACT == 1) {
#pragma unroll
            for (int j = 0; j < 4; ++j) { const float a = fmaxf(v[j], 0.f); v[j] = a * a; }
        }
        *(GAS u32x2*)(O + (size_t)row * ldc + col) = (u32x2){cvt_pk_bf16(v[0], v[1]), cvt_pk_bf16(v[2], v[3])};
    }
};
struct CEpiRes {
    GAS bf16_t* X; const GAS float* Xin; bool xf32;
    const GAS float* gate; const GAS float* bias; const GAS float* scale;
    GAS bf16_t* Hn; const GAS float* gsn; GAS unsigned long long* rsn;
    __device__ __forceinline__ void apply(int row, int col, f32x4 v) const {
        f32x4 ga = *(const GAS f32x4*)(gate + col);
        if (scale) ga = ga * *(const GAS f32x4*)(scale + col);
        if (bias) v = v + *(const GAS f32x4*)(bias + col);
        const size_t o = (size_t)row * 2048 + col;
        f32x4 xi;
        if (xf32) xi = *(const GAS f32x4*)(Xin + o);
        else { const u32x2 w = *(const GAS u32x2*)(X + o); xi = (f32x4){__builtin_bit_cast(float, w.x << 16), __builtin_bit_cast(float, w.x & 0xffff0000u), __builtin_bit_cast(float, w.y << 16), __builtin_bit_cast(float, w.y & 0xffff0000u)}; }
        const f32x4 x = xi + ga * v;
        *(GAS u32x2*)(X + o) = (u32x2){cvt_pk_bf16(x[0], x[1]), cvt_pk_bf16(x[2], x[3])};
        if (Hn) { const f32x4 h = x * *(const GAS f32x4*)(gsn + col); float ss = (x[0] * x[0] + x[1] * x[1]) + (x[2] * x[2] + x[3] * x[3]);
            *(GAS u32x2*)(Hn + o) = (u32x2){cvt_pk_bf16(h[0], h[1]), cvt_pk_bf16(h[2], h[3])};
            ss += __shfl_xor(ss, 16); ss += __shfl_xor(ss, 32); if ((threadIdx.x & 48) == 0) __hip_atomic_fetch_add(rsn + row, (unsigned long long)(ss * 1048576.0f), __ATOMIC_RELAXED, __HIP_MEMORY_SCOPE_AGENT); }
    }
};
template <class Epi>
__device__ __forceinline__ void ctx_gemm(PG8_LAS unsigned char* L, int bid, int G, const GAS bf16_t* A, int lda, const GAS bf16_t* Bt, int ldb, int n_lo, int n_hi, int K, int agrp, int row0, const Epi& E) {
    int tid_ = threadIdx.x; asm volatile("" : "+v"(tid_));
    const int w = __builtin_amdgcn_readfirstlane(tid_ >> 6), lane = tid_ & 63, q = lane >> 4, li = lane & 15;
    const int ncb = (n_hi - n_lo) >> 6, nitems = 8 * ncb, ksl = K >> 3, nst = ksl >> 6;
    const int xcd_ = bid & 7, slot_ = bid >> 3, cpp_ = G >> 6;
    for (int pass = 0; ; ++pass) {
        int rb, cb;
        if ((G & 63) == 0) { rb = slot_ & 7; cb = 8 * ((slot_ >> 3) + cpp_ * pass) + xcd_; if (8 * cpp_ * pass >= ncb) break; if (cb >= ncb) { asm volatile("" ::: "memory"); continue; } }
        else { const int item = bid + G * pass; if (item >= nitems) break; rb = item & 7; cb = item >> 3; }
        const int m0 = 64 * rb, n0 = n_lo + 64 * cb;
        const int acol = agrp ? (n0 / agrp) * agrp : 0;
        const GAS bf16_t* ap = A + (size_t)(m0 + li) * lda + acol + w * ksl + 8 * q;
        const GAS bf16_t* bp = Bt + (size_t)(n0 + li) * ldb + w * ksl + 8 * q;
        f32x4 acc[4][4];
#pragma unroll
        for (int rt = 0; rt < 4; ++rt)
#pragma unroll
            for (int ct = 0; ct < 4; ++ct) acc[rt][ct] = (f32x4){0.f, 0.f, 0.f, 0.f};
        bf16x8 a0[4][2], b0[4][2], a1[4][2], b1[4][2];
#define CG_LOAD(dA, dB, s) do { _Pragma("unroll") for (int t = 0; t < 4; ++t) _Pragma("unroll") for (int hh = 0; hh < 2; ++hh) { \
            dA[t][hh] = *(const GAS bf16x8*)(ap + (size_t)(16 * t) * lda + (s) * 64 + hh * 32); dB[t][hh] = *(const GAS bf16x8*)(bp + (size_t)(16 * t) * ldb + (s) * 64 + hh * 32); } } while (0)
#define CG_MMA(dA, dB) do { _Pragma("unroll") for (int hh = 0; hh < 2; ++hh) _Pragma("unroll") for (int rt = 0; rt < 4; ++rt) _Pragma("unroll") for (int ct = 0; ct < 4; ++ct) \
            acc[rt][ct] = __builtin_amdgcn_mfma_f32_16x16x32_bf16(dB[ct][hh], dA[rt][hh], acc[rt][ct], 0, 0, 0); } while (0)
        CG_LOAD(a0, b0, 0);
        for (int s = 0; s < nst; s += 2) {
            if (s + 1 < nst) CG_LOAD(a1, b1, s + 1);
            CG_MMA(a0, b0);
            if (s + 2 < nst) CG_LOAD(a0, b0, s + 2);
            if (s + 1 < nst) CG_MMA(a1, b1);
        }
#undef CG_LOAD
#undef CG_MMA
#pragma unroll
        for (int rt = 0; rt < 4; ++rt)
#pragma unroll
            for (int ct = 0; ct < 4; ++ct) *(PG8_LAS f32x4*)(L + ((w * 16 + rt * 4 + ct) * 64 + lane) * 16) = acc[rt][ct];
        asm volatile("s_waitcnt lgkmcnt(0)" ::: "memory"); __builtin_amdgcn_s_barrier(); asm volatile("" ::: "memory");
#pragma unroll
        for (int u = 0; u < 2; ++u) {
            const int tt = 2 * w + u, rt = tt >> 2, ct = tt & 3;
            f32x4 v = {0.f, 0.f, 0.f, 0.f};
#pragma unroll
            for (int ww = 0; ww < 8; ++ww) v = v + *(const PG8_LAS f32x4*)(L + ((ww * 16 + tt) * 64 + lane) * 16);
            E.apply(row0 + m0 + 16 * rt + li, n0 + 16 * ct + 4 * q, v);
        }
        asm volatile("s_waitcnt lgkmcnt(0)" ::: "memory"); __builtin_amdgcn_s_barrier(); asm volatile("" ::: "memory");
    }
}
}

constexpr int NWAVES = 8;
constexpr int D = 2048, SEQ = 8192, NLAT = 16384, CTXL = 256, NCTX = 512, MR = NLAT + NCTX;
constexpr int DFF = 8192, INC = 7168, NMOD = 12288;
constexpr float EPS = 1e-6f;

constexpr size_t MiB = 1u << 20;
constexpr size_t WS_CTL = 0, CTL_ZERO_BYTES = 3 * MiB;
constexpr size_t WS_RS = 1 * MiB;
constexpr size_t WS_MODS = 3 * MiB;
constexpr size_t WS_LB = 3 * MiB + 640 * 1024;
constexpr size_t WS_GS = 3 * MiB + 704 * 1024;
constexpr size_t WS_WIN = 4 * MiB;
constexpr size_t WS_WOUT = 60 * MiB;
constexpr size_t WS_WUP = 76 * MiB;
constexpr size_t WS_WDN = 204 * MiB;
constexpr size_t WS_WP = 332 * MiB;
constexpr size_t WS_WG = 348 * MiB;
constexpr size_t WS_X = 352 * MiB;
constexpr size_t WS_H = 484 * MiB;
constexpr size_t WS_P = 550 * MiB;
constexpr size_t WS_G = 781 * MiB;
constexpr size_t WS_OF = 913 * MiB;
constexpr size_t WS_OB = 979 * MiB;
constexpr size_t WS_Y = 1045 * MiB;
constexpr size_t WS_HID = 550 * MiB;
constexpr size_t WS_HS = 1111 * MiB;
constexpr size_t WS_DS = 1127 * MiB;
constexpr size_t WS_WSB = 1128 * MiB;
constexpr size_t WS_CB = 1129 * MiB;
constexpr size_t WS_QH = 1130 * MiB;
constexpr size_t WS_KH = 1163 * MiB;
constexpr size_t WS_VH = 1229 * MiB;
constexpr size_t WS_END = 1262 * MiB;
constexpr int CW_BAR = 4096;

constexpr int RING_BYTES = 131072;
constexpr int LDSCTL_OFF = RING_BYTES, MISC_OFF = LDSCTL_OFF + 320;
constexpr int LDS_BYTES = 147456;

#define LAS __attribute__((address_space(3)))
typedef unsigned short bf16;
typedef unsigned v4u __attribute__((ext_vector_type(4)));
typedef unsigned v2u __attribute__((ext_vector_type(2)));
typedef float f32x4 __attribute__((ext_vector_type(4)));
#define LDS_WAIT() asm volatile("s_waitcnt lgkmcnt(0)" ::: "memory")
__device__ __forceinline__ unsigned f2bf(float f) { unsigned u = __builtin_bit_cast(unsigned, f); return (u + 0x7fffu + ((u >> 16) & 1u)) >> 16; }
__device__ __forceinline__ unsigned pk2(float lo, float hi) { return f2bf(lo) | (f2bf(hi) << 16); }
__device__ __forceinline__ float bf2f(unsigned short b) { return __builtin_bit_cast(float, ((unsigned)b) << 16); }
__device__ __forceinline__ float bflo(unsigned w) { return __builtin_bit_cast(float, w << 16); }
__device__ __forceinline__ float bfhi(unsigned w) { return __builtin_bit_cast(float, w & 0xffff0000u); }

#define XB_TMO      128
#define XB_XCNT(j)  (256  + 64 * (j))
#define XB_XSUB(j)  (1280 + 64 * (j))
#define XB_XGEN(j)  (2304 + 64 * (j))
#define XB_TOP      3328
#define XB_TOPGEN   3392
#define XCD_BAR_WORDS 3456
#define XB_SPIN_CAP (1u << 18)
__device__ __forceinline__ unsigned xb_ld(unsigned* p)              { return __hip_atomic_load(p, __ATOMIC_RELAXED, __HIP_MEMORY_SCOPE_AGENT); }
__device__ __forceinline__ unsigned xb_add(unsigned* p, unsigned v) { return __hip_atomic_fetch_add(p, v, __ATOMIC_RELAXED, __HIP_MEMORY_SCOPE_AGENT); }
__device__ __forceinline__ unsigned xb_xcc_id() { return (unsigned)__builtin_amdgcn_s_getreg((3 << 11) | 20) & 0xFu; }
#define XB_SPIN(cond, bar) do { unsigned _sp = 0; while (cond) { __builtin_amdgcn_s_sleep(1); \
    if ((++_sp & 255u) == 0u) { if (xb_ld(&(bar)[XB_TMO])) break; if (_sp > XB_SPIN_CAP) { atomicAdd(&(bar)[XB_TMO], 1u); break; } } } } while (0)
struct XcdBarrier { unsigned* bar; unsigned x; volatile LAS unsigned* st; };
__device__ __forceinline__ XcdBarrier xcd_barrier_post(unsigned* bar, volatile LAS unsigned* st) {
    XcdBarrier b; b.bar = bar; b.x = xb_xcc_id(); b.st = st;
    if (threadIdx.x == 0) (void)xb_add(&bar[XB_XCNT(b.x)], 1u);
    return b;
}
__device__ __forceinline__ void xcd_barrier_complete(unsigned* bar, unsigned x, unsigned& nloc, unsigned& nx) {
    const unsigned G = gridDim.x * gridDim.y * gridDim.z;
    unsigned sum, cnt, mine, sp = 0u;
    for (;;) {
        sum = 0u; cnt = 0u; mine = 0u;
#pragma unroll
        for (unsigned j = 0; j < 16; ++j) { const unsigned c = xb_ld(&bar[XB_XCNT(j)]); sum += c; cnt += (c > 0u) ? 1u : 0u; mine = (j == x) ? c : mine; }
        if (sum == G) break;
        __builtin_amdgcn_s_sleep(1);
        if ((++sp & 255u) == 0u) { if (xb_ld(&bar[XB_TMO])) break; if (sp > XB_SPIN_CAP) { atomicAdd(&bar[XB_TMO], 1u); break; } }
    }
    nloc = mine > 0u ? mine : 1u; nx = cnt > 0u ? cnt : 1u;
}
__device__ __forceinline__ void xcd_barrier(const XcdBarrier& b) {
    asm volatile("s_waitcnt vmcnt(0)" ::: "memory");
    __syncthreads();
    if (threadIdx.x == 0) {
        unsigned* bar = b.bar;
        __builtin_amdgcn_s_waitcnt(0);
        unsigned nloc = b.st[0], nx = b.st[1];
        if (nloc == 0u) { xcd_barrier_complete(bar, b.x, nloc, nx); b.st[0] = nloc; b.st[1] = nx; }
        const unsigned old = xb_add(&bar[XB_XSUB(b.x)], 1u);
        const unsigned gen = old / nloc;
        if (old + 1u == (gen + 1u) * nloc) {
            __builtin_amdgcn_fence(__ATOMIC_RELEASE, "agent");
            asm volatile("s_waitcnt vmcnt(0)" ::: "memory");
            const unsigned og = xb_add(&bar[XB_TOP], 1u);
            const unsigned tg = og / nx;
            if (og + 1u == (tg + 1u) * nx) xb_add(&bar[XB_TOPGEN], 1u);
            else XB_SPIN(xb_ld(&bar[XB_TOPGEN]) == tg, bar);
            __builtin_amdgcn_fence(__ATOMIC_ACQUIRE, "agent");
            xb_add(&bar[XB_XGEN(b.x)], 1u);
            asm volatile("s_waitcnt vmcnt(0)" ::: "memory");
        } else {
            XB_SPIN(xb_ld(&bar[XB_XGEN(b.x)]) == gen, bar);
            __builtin_amdgcn_fence(__ATOMIC_ACQUIRE, "agent");
            asm volatile("s_waitcnt vmcnt(0)" ::: "memory");
        }
    }
    __syncthreads();
}

struct Frame {
    LAS unsigned char* lds;
    int tid, lane, wave, G, bid;
    GAS float* out;
    GAS unsigned char* ws;
};
struct Args { const float* in[22]; float* out; unsigned char* ws; int ph_lo, ph_hi; };
__device__ __forceinline__ const GAS float* in_ptr(int i) { unsigned long long p = (unsigned long long)__builtin_amdgcn_kernarg_segment_ptr(); asm volatile("" : "+s"(p)); return (const GAS float*)(((const __attribute__((address_space(4))) Args*)p)->in[i]); }
#define FRESH(F) do { asm volatile("" : "+v"(F.tid)); F.lane = F.tid & 63; F.wave = __builtin_amdgcn_readfirstlane(F.tid >> 6); asm volatile("" : "+s"(F.ws)); } while (0)
__device__ __forceinline__ float wave_sum(float v) {
#pragma unroll
    for (int o = 1; o < 64; o <<= 1) v += __shfl_xor(v, o);
    return v;
}

__device__ __forceinline__ void p0_transpose_item(const GAS float* W, int K, int N, GAS bf16* WT, LAS float* scr, int item, int lane) {
    const int nblk = N / 32, kb = item / nblk, nb = item % nblk, k0 = 64 * kb, n0 = 32 * nb;
#pragma unroll 8
    for (int i = 0; i < 32; ++i) { const int kk = 2 * i + (lane >> 5); scr[kk * 33 + (lane & 31)] = W[(size_t)(k0 + kk) * N + n0 + (lane & 31)]; }
    LDS_WAIT(); asm volatile("" ::: "memory");
    const int c = lane & 7;
#pragma unroll
    for (int j = 0; j < 4; ++j) { const int n = (lane >> 3) + 8 * j; const LAS float* s = scr + (8 * c) * 33 + n;
        v4u o; o.x = pk2(s[0 * 33], s[1 * 33]); o.y = pk2(s[2 * 33], s[3 * 33]); o.z = pk2(s[4 * 33], s[5 * 33]); o.w = pk2(s[6 * 33], s[7 * 33]);
        *(GAS v4u*)(WT + (size_t)(n0 + n) * K + k0 + 8 * c) = o; }
    LDS_WAIT(); asm volatile("" ::: "memory");
}

__device__ __forceinline__ void prologue_phase(Frame& F) {
    const int gw = F.bid * NWAVES + F.wave, NGW = F.G * NWAVES;
    {
        LAS float* scr = (LAS float*)(F.lds + 36864 + F.wave * 8448);
        constexpr int I_IN = (D / 64) * (INC / 32), I_SQ = (D / 64) * (D / 32), I_UP = (D / 64) * (DFF / 32), I_DN = (DFF / 64) * (D / 32), I_G = (512 / 64) * (512 / 32);
        constexpr int NITEMS = 2 * I_IN + 2 * I_SQ + 4 * I_UP + 4 * I_DN + 2 * I_SQ + 8 * I_G;
        for (int it = gw; it < NITEMS; it += NGW) {
            int r = it;
            if (r < 2 * I_IN) { const int e = r / I_IN; p0_transpose_item(in_ptr(8) + (size_t)e * D * INC, D, INC, (GAS bf16*)(F.ws + WS_WIN) + (size_t)e * INC * D, scr, r % I_IN, F.lane); continue; } r -= 2 * I_IN;
            if (r < 2 * I_SQ) { const int e = r / I_SQ; p0_transpose_item(in_ptr(9) + (size_t)e * D * D, D, D, (GAS bf16*)(F.ws + WS_WOUT) + (size_t)e * D * D, scr, r % I_SQ, F.lane); continue; } r -= 2 * I_SQ;
            if (r < 4 * I_UP) { const int l = r / I_UP; p0_transpose_item(in_ptr(19) + (size_t)l * D * DFF, D, DFF, (GAS bf16*)(F.ws + WS_WUP) + (size_t)l * DFF * D, scr, r % I_UP, F.lane); continue; } r -= 4 * I_UP;
            if (r < 4 * I_DN) { const int l = r / I_DN; p0_transpose_item(in_ptr(20) + (size_t)l * DFF * D, DFF, D, (GAS bf16*)(F.ws + WS_WDN) + (size_t)l * D * DFF, scr, r % I_DN, F.lane); continue; } r -= 4 * I_DN;
            if (r < 2 * I_SQ) { const int o = r / I_SQ; p0_transpose_item(in_ptr(15) + (size_t)o * D * D, D, D, (GAS bf16*)(F.ws + WS_WP) + (size_t)o * D * D, scr, r % I_SQ, F.lane); continue; } r -= 2 * I_SQ;
            { const int og = r / I_G; p0_transpose_item(in_ptr(16) + (size_t)og * 512 * 512, 512, 512, (GAS bf16*)(F.ws + WS_WG) + (size_t)og * 512 * 512, scr, r % I_G, F.lane); }
        }
    }
    {
        const GAS float* wsp = in_ptr(12); GAS bf16* wsb = (GAS bf16*)(F.ws + WS_WSB);
        for (int i = (F.bid * NWAVES * 64 + F.tid) * 4; i < 2 * 8 * 128 * 128; i += F.G * NWAVES * 64 * 4) { const f32x4 v = *(const GAS f32x4*)(wsp + i); *(GAS v2u*)(wsb + i) = (v2u){pk2(v[0], v[1]), pk2(v[2], v[3])}; }
    }
    if (F.bid == 0) {
        const GAS float* lg = in_ptr(10); GAS float* lb = (GAS float*)(F.ws + WS_LB);
        for (int i = F.tid; i < 2048; i += NWAVES * 64) {
            const int d = i >> 10, k = i & 1023;
            const float l0 = lg[(d * 2 + 0) * 1024 + k], l1 = lg[(d * 2 + 1) * 1024 + k], mx = fmaxf(l0, l1);
            const float e0 = expf(l0 - mx), e1 = expf(l1 - mx), p0 = e0 / (e0 + e1), p1 = e1 / (e0 + e1);
            lb[0 * 2048 + i] = p0 - p0; lb[1 * 2048 + i] = (p0 + p1) - p0;
        }
    }
    {
        LAS float* sv = (LAS float*)F.lds;
        LAS float* red = (LAS float*)(F.lds + 24576);
        for (int i = F.tid; i < 3 * D; i += NWAVES * 64) { const int r = i / D, k = i % D; const float x = r < 2 ? in_ptr(1)[r * D + k] : in_ptr(3)[k]; sv[i] = x / (1.0f + expf(-x)); }
        __syncthreads();
        GAS float* mods = (GAS float*)(F.ws + WS_MODS);
        const int cl = F.lane & 31, kh = F.lane >> 5;
        for (int item = F.bid; item < 4 * 96; item += F.G) {
            const int l = item / 96, n0 = (item % 96) * 128;
            const GAS float* W = in_ptr(4) + (size_t)l * D * NMOD + n0 + cl * 4;
            f32x4 a0 = {0.f, 0.f, 0.f, 0.f}, a1 = a0, a2 = a0;
#pragma unroll 8
            for (int i = 0; i < 128; ++i) {
                const int k = F.wave * 256 + 2 * i + kh;
                const f32x4 w4 = *(const GAS f32x4*)(W + (size_t)k * NMOD);
                a0 += sv[k] * w4; a1 += sv[D + k] * w4; a2 += sv[2 * D + k] * w4;
            }
#pragma unroll
            for (int j = 0; j < 4; ++j) { a0[j] += __shfl_xor(a0[j], 32); a1[j] += __shfl_xor(a1[j], 32); a2[j] += __shfl_xor(a2[j], 32); }
            if (F.lane < 32) { *(LAS f32x4*)(red + (F.wave * 3 + 0) * 128 + cl * 4) = a0; *(LAS f32x4*)(red + (F.wave * 3 + 1) * 128 + cl * 4) = a1; *(LAS f32x4*)(red + (F.wave * 3 + 2) * 128 + cl * 4) = a2; }
            __syncthreads();
            if (F.tid < 384) { const int r = F.tid / 128, c = F.tid % 128; float s = 0.f;
#pragma unroll
                for (int w = 0; w < 8; ++w) s += red[(w * 3 + r) * 128 + c];
                mods[(size_t)(l * 3 + r) * NMOD + n0 + c] = s + in_ptr(5)[(size_t)l * NMOD + n0 + c]; }
            __syncthreads();
        }
    }
}

__device__ __forceinline__ void cb_tables(Frame& F, int L0, int L1, int gw, int NGW) {
    const GAS float* mods = (const GAS float*)(F.ws + WS_MODS);
    {
        GAS float* CB = (GAS float*)(F.ws + WS_CB);
        for (int L = L0; L < L1; ++L)
            for (int j = 0; j < 2; ++j) {
                const int N = j ? DFF : ((L & 1) ? D : INC);
                const GAS bf16* WT = j ? (const GAS bf16*)(F.ws + WS_WUP) + (size_t)L * DFF * D : ((L & 1) ? (const GAS bf16*)(F.ws + WS_WP) + (size_t)(L >> 1) * D * D : (const GAS bf16*)(F.ws + WS_WIN) + (size_t)(L >> 1) * INC * D);
                const GAS float* sh = mods + (size_t)L * 3 * NMOD + (j ? 6144 : 0);
                f32x4 s0[8], s1[8], s2[8];
#pragma unroll
                for (int jj = 0; jj < 4; ++jj)
#pragma unroll
                    for (int h2 = 0; h2 < 2; ++h2) { const int k = 8 * F.lane + 512 * jj + 4 * h2;
                        s0[2 * jj + h2] = *(const GAS f32x4*)(sh + k); s1[2 * jj + h2] = *(const GAS f32x4*)(sh + NMOD + k); s2[2 * jj + h2] = *(const GAS f32x4*)(sh + 2 * NMOD + k); }
                for (int n = gw; n < N; n += NGW) {
                    float a0 = 0.f, a1 = 0.f, a2 = 0.f;
                    v4u wv[4];
#pragma unroll
                    for (int jj = 0; jj < 4; ++jj) wv[jj] = *(const GAS v4u*)(WT + (size_t)n * D + 8 * F.lane + 512 * jj);
#pragma unroll
                    for (int jj = 0; jj < 4; ++jj) {
                        const float wf[8] = {bflo(wv[jj].x), bfhi(wv[jj].x), bflo(wv[jj].y), bfhi(wv[jj].y), bflo(wv[jj].z), bfhi(wv[jj].z), bflo(wv[jj].w), bfhi(wv[jj].w)};
#pragma unroll
                        for (int h2 = 0; h2 < 2; ++h2)
#pragma unroll
                            for (int u = 0; u < 4; ++u) { a0 += s0[2 * jj + h2][u] * wf[4 * h2 + u]; a1 += s1[2 * jj + h2][u] * wf[4 * h2 + u]; a2 += s2[2 * jj + h2][u] * wf[4 * h2 + u]; }
                    }
                    a0 = wave_sum(a0); a1 = wave_sum(a1); a2 = wave_sum(a2);
                    if (F.lane == 0) { GAS float* o = CB + (size_t)L * 3 * 16384 + (j ? 8192 : 0) + n; o[0] = a0; o[16384] = a1; o[2 * 16384] = a2; }
                }
            }
    }
}
__device__ __forceinline__ void prep_phase(Frame& F) {
    const int gw = F.bid * NWAVES + F.wave, NGW = F.G * NWAVES;
    const GAS float* mods = (const GAS float*)(F.ws + WS_MODS);
    {
        GAS bf16* H = (GAS bf16*)(F.ws + WS_H); GAS unsigned long long* RS = (GAS unsigned long long*)(F.ws + WS_RS);
        const GAS float* gvec = in_ptr(6);
        for (int row = gw; row < MR; row += NGW) {
            const GAS float* xr = row < NLAT ? in_ptr(0) + (size_t)row * D : in_ptr(2) + (size_t)(row - NLAT) * D;
            const int mr = row < SEQ ? 0 : (row < NLAT ? 1 : 2);
            f32x4 v[8]; float ss = 0.f;
#pragma unroll
            for (int j = 0; j < 8; ++j) { v[j] = *(const GAS f32x4*)(xr + 4 * (F.lane + 64 * j)); ss += (v[j][0] * v[j][0] + v[j][1] * v[j][1]) + (v[j][2] * v[j][2] + v[j][3] * v[j][3]); }
            ss = wave_sum(ss);
            if (F.lane == 0) RS[row] = (unsigned long long)(ss * 1048576.0f);
#pragma unroll
            for (int j = 0; j < 8; ++j) {
                const int col = 4 * (F.lane + 64 * j);
                const f32x4 g4 = *(const GAS f32x4*)(gvec + col), s4 = *(const GAS f32x4*)(mods + (size_t)mr * NMOD + 2048 + col);
                const f32x4 y = v[j] * g4 * (1.0f + s4);
                v2u w; w.x = pk2(y[0], y[1]); w.y = pk2(y[2], y[3]);
                *(GAS v2u*)(H + (size_t)row * D + col) = w;
            }
        }
    }
    {
        GAS float* GS = (GAS float*)(F.ws + WS_GS);
        for (int i = F.bid * NWAVES * 64 + F.tid; i < 4 * 2 * 3 * D; i += F.G * NWAVES * 64) {
            const int col = i % D, mr = (i / D) % 3, j = (i / (3 * D)) % 2, L = i / (6 * D);
            const float g = (j ? in_ptr(7) : in_ptr(6))[(size_t)L * D + col], sc = mods[((size_t)L * 3 + mr) * NMOD + (j ? 8192 : 2048) + col];
            GS[i] = g * (1.0f + sc);
        }
    }
    cb_tables(F, 0, 1, gw, NGW);
}
__device__ __forceinline__ void final_norm_phase(Frame& F) {
    const int gw = F.bid * NWAVES + F.wave, NGW = F.G * NWAVES;
    const GAS float* gvec = in_ptr(21);
    for (int row = gw; row < NLAT; row += NGW) {
        GAS float* xr = F.out + (size_t)row * D;
        f32x4 v[8]; float ss = 0.f;
#pragma unroll
        for (int j = 0; j < 8; ++j) { v[j] = *(const GAS f32x4*)(xr + 4 * (F.lane + 64 * j)); ss += (v[j][0] * v[j][0] + v[j][1] * v[j][1]) + (v[j][2] * v[j][2] + v[j][3] * v[j][3]); }
        const float rstd = rsqrtf(wave_sum(ss) * (1.0f / D) + EPS);
#pragma unroll
        for (int j = 0; j < 8; ++j) { const int col = 4 * (F.lane + 64 * j); *(GAS f32x4*)(xr + col) = (v[j] * rstd) * *(const GAS f32x4*)(gvec + col); }
    }
}

constexpr int SC_RS = 272, SC_TS = 144;
constexpr int SC_QB = 0, SC_QS = 17408, SC_KS0 = 34816, SC_KS1 = SC_KS0 + 16 * SC_RS, SC_KS2 = SC_KS1 + 32 * SC_RS, SC_KS3 = SC_KS2 + 48 * SC_RS;
constexpr int SC_KST = SC_KS3 + 64 * SC_RS, SC_VT = SC_KST + 128 * SC_TS, SC_A = SC_VT + 128 * SC_TS, SC_TOT = SC_A + 64 * SC_TS, SC_D = SC_TOT + 4096, SC_END = SC_D + 512;
static_assert(SC_END <= RING_BYTES, "scan LDS map");
#define SC_LBAR() do { asm volatile("s_waitcnt lgkmcnt(0)" ::: "memory"); __builtin_amdgcn_s_barrier(); asm volatile("" ::: "memory"); } while (0)
typedef short bf16x8_t __attribute__((ext_vector_type(8)));
typedef float f32x2_t __attribute__((ext_vector_type(2)));
__device__ __forceinline__ unsigned cvtpk(float lo, float hi) { return pg8::cvt_pk_bf16(lo, hi); }

template <bool STATE_ONLY>
__device__ __forceinline__ void scan_fast_phase(Frame& F) {
    const GAS float* Gl = (const GAS float*)(F.ws + WS_G);
    const GAS bf16* QH = (const GAS bf16*)(F.ws + WS_QH); const GAS bf16* VH = (const GAS bf16*)(F.ws + WS_VH);
    GAS float* HS = (GAS float*)(F.ws + WS_HS); GAS float* DS = (GAS float*)(F.ws + WS_DS);
    LAS unsigned char* L = F.lds;
    const int w = F.wave, lane = F.lane, q = lane >> 4, li = lane & 15;
    if (!STATE_ONLY) { for (int u = F.tid; u < (64 * SC_TS) / 4; u += NWAVES * 64) ((LAS unsigned*)(L + SC_A))[u] = 0u; }
    for (int item = F.bid; item < 256; item += F.G) {
        const int seq = item >> 3, seg = item & 7, b = seq >> 4, h = (seq >> 1) & 7, dir = seq & 1;
        const int cs = seg < 4 ? 17 * seg : 68 + 16 * (seg - 4), ce = seg < 4 ? 17 * (seg + 1) : 68 + 16 * (seg - 3);
        f32x4 S[8];
#pragma unroll
        for (int kt = 0; kt < 8; ++kt) S[kt] = (f32x4){0.f, 0.f, 0.f, 0.f};
        if (!STATE_ONLY) {
            for (int jj = 0; jj < seg; ++jj) {
                const GAS float* hp = HS + ((size_t)((seq * 8 + jj) * 8 + w) * 64 + lane) * 32; const GAS float* dp = DS + (size_t)(seq * 8 + jj) * 128;
#pragma unroll
                for (int kt = 0; kt < 8; ++kt) { const f32x4 hv = *(const GAS f32x4*)(hp + 4 * kt), dv = *(const GAS f32x4*)(dp + 16 * kt + 4 * q); S[kt] = dv * S[kt] + hv; }
            }
        }
        float segtot0 = 0.f, segtot1 = 0.f;
        f32x2_t gx[8]; unsigned qw[8], vw[8];
#define SC_LOAD(ci_) do { const int ci__ = (ci_); const int p0 = ci__ < 4 ? 64 * ci__ : 64 * (ci__ - 4); \
        const size_t hb = ci__ < 4 ? (size_t)16 * SEQ * 128 + ((size_t)((b * 8 + h) * CTXL + (dir ? CTXL - 1 - p0 : p0))) * 128 : ((size_t)((b * 8 + h) * SEQ + (dir ? SEQ - 1 - p0 : p0))) * 128; \
        _Pragma("unroll") for (int r = 0; r < 8; ++r) { const size_t eo = dir ? hb - (size_t)(8 * w + r) * 128 + 2 * lane : hb + (size_t)(8 * w + r) * 128 + 2 * lane; \
            gx[r] = *(const GAS f32x2_t*)(Gl + (size_t)dir * pg8::HM_ELEMS + eo); \
            vw[r] = *(const GAS unsigned*)(VH + eo); \
            if (!STATE_ONLY) qw[r] = *(const GAS unsigned*)(QH + eo); } } while (0)
        SC_LOAD(cs);
        for (int ci = cs; ci < ce; ++ci) {
            float l0[8], l1[8], kf0[8], kf1[8];
            { float a0 = 0.f, a1 = 0.f;
#pragma unroll
              for (int r = 0; r < 8; ++r) { a0 += gx[r][0]; a1 += gx[r][1]; l0[r] = a0; l1[r] = a1; kf0[r] = 1.0f - __expf(gx[r][0]); kf1[r] = 1.0f - __expf(gx[r][1]); }
              *(LAS f32x2_t*)(L + SC_TOT + (w * 128 + 2 * lane) * 4) = (f32x2_t){a0, a1}; }
            SC_LBAR();
            float rr0[5], rr1[5], pre0 = 0.f, pre1 = 0.f;
            { float s0 = 0.f, s1 = 0.f; rr0[0] = 0.f; rr1[0] = 0.f;
#pragma unroll
              for (int ww = 0; ww < 8; ++ww) { const f32x2_t t = *(const LAS f32x2_t*)(L + SC_TOT + (ww * 128 + 2 * lane) * 4); if (ww == w) { pre0 = s0; pre1 = s1; } s0 += t[0]; s1 += t[1]; if (ww & 1) { rr0[(ww + 1) >> 1] = s0; rr1[(ww + 1) >> 1] = s1; } } }
            const int c = w >> 1;
            float rc0 = 0.f, rc1 = 0.f, rn0 = 0.f, rn1 = 0.f;
#pragma unroll
            for (int cc = 0; cc < 4; ++cc) if (cc == c) { rc0 = rr0[cc]; rc1 = rr1[cc]; rn0 = rr0[cc + 1]; rn1 = rr1[cc + 1]; }
            if (STATE_ONLY) {
                unsigned k0p[4], k1p[4], v0p[4], v1p[4];
#pragma unroll
                for (int r = 0; r < 8; r += 2) {
                    const float fa0 = __expf(rr0[4] - (pre0 + l0[r])), fa1 = __expf(rr1[4] - (pre1 + l1[r])), fb0 = __expf(rr0[4] - (pre0 + l0[r + 1])), fb1 = __expf(rr1[4] - (pre1 + l1[r + 1]));
                    k0p[r >> 1] = cvtpk(kf0[r] * fa0, kf0[r + 1] * fb0); k1p[r >> 1] = cvtpk(kf1[r] * fa1, kf1[r + 1] * fb1);
                    v0p[r >> 1] = (vw[r] & 0xffffu) | (vw[r + 1] << 16); v1p[r >> 1] = (vw[r] >> 16) | (vw[r + 1] & 0xffff0000u);
                }
                *(LAS v4u*)(L + SC_KST + (2 * lane) * SC_TS + 16 * w) = (v4u){k0p[0], k0p[1], k0p[2], k0p[3]}; *(LAS v4u*)(L + SC_KST + (2 * lane + 1) * SC_TS + 16 * w) = (v4u){k1p[0], k1p[1], k1p[2], k1p[3]};
                *(LAS v4u*)(L + SC_VT + (2 * lane) * SC_TS + 16 * w) = (v4u){v0p[0], v0p[1], v0p[2], v0p[3]}; *(LAS v4u*)(L + SC_VT + (2 * lane + 1) * SC_TS + 16 * w) = (v4u){v1p[0], v1p[1], v1p[2], v1p[3]};
                if (w == 0) *(LAS f32x2_t*)(L + SC_D + 8 * lane) = (f32x2_t){__expf(rr0[4]), __expf(rr1[4])};
                segtot0 += rr0[4]; segtot1 += rr1[4];
            } else {
                const float R0 = __expf(rc0), R1 = __expf(rc1);
                float T0[5], T1[5];
#pragma unroll
                for (int cp = 1; cp < 5; ++cp) { T0[cp] = __expf(rr0[cp] - rn0); T1[cp] = __expf(rr1[cp] - rn1); }
                unsigned k0p[4], k1p[4], v0p[4], v1p[4];
#pragma unroll
                for (int r = 0; r < 8; ++r) {
                    const int i = 8 * w + r;
                    const float B0 = pre0 + l0[r], B1 = pre1 + l1[r];
                    const float E0 = __expf(B0 - rc0), E1 = __expf(B1 - rc1), F0 = __expf(rn0 - B0), F1 = __expf(rn1 - B1), D0 = __expf(fminf(rc0 - B0, 80.f)), D1 = __expf(fminf(rc1 - B1, 80.f));
                    const float q0 = bflo(qw[r]) * E0, q1 = bfhi(qw[r]) * E1, k0 = kf0[r], k1 = kf1[r];
                    *(LAS unsigned*)(L + SC_QS + i * SC_RS + 4 * lane) = cvtpk(q0, q1);
                    *(LAS unsigned*)(L + SC_QB + i * SC_RS + 4 * lane) = cvtpk(q0 * R0, q1 * R1);
                    const float kf0 = k0 * F0, kf1 = k1 * F1;
                    const unsigned kd = cvtpk(k0 * D0, k1 * D1);
                    if (c == 0) { *(LAS unsigned*)(L + SC_KS0 + i * SC_RS + 4 * lane) = kd; *(LAS unsigned*)(L + SC_KS1 + i * SC_RS + 4 * lane) = cvtpk(kf0 * T0[1], kf1 * T1[1]); *(LAS unsigned*)(L + SC_KS2 + i * SC_RS + 4 * lane) = cvtpk(kf0 * T0[2], kf1 * T1[2]); *(LAS unsigned*)(L + SC_KS3 + i * SC_RS + 4 * lane) = cvtpk(kf0 * T0[3], kf1 * T1[3]); }
                    else if (c == 1) { *(LAS unsigned*)(L + SC_KS1 + i * SC_RS + 4 * lane) = kd; *(LAS unsigned*)(L + SC_KS2 + i * SC_RS + 4 * lane) = cvtpk(kf0 * T0[2], kf1 * T1[2]); *(LAS unsigned*)(L + SC_KS3 + i * SC_RS + 4 * lane) = cvtpk(kf0 * T0[3], kf1 * T1[3]); }
                    else if (c == 2) { *(LAS unsigned*)(L + SC_KS2 + i * SC_RS + 4 * lane) = kd; *(LAS unsigned*)(L + SC_KS3 + i * SC_RS + 4 * lane) = cvtpk(kf0 * T0[3], kf1 * T1[3]); }
                    else { *(LAS unsigned*)(L + SC_KS3 + i * SC_RS + 4 * lane) = kd; }
                    const float ks0 = kf0 * T0[4], ks1 = kf1 * T1[4];
                    if (r & 1) { k0p[r >> 1] |= (cvtpk(ks0, ks0) << 16); k1p[r >> 1] |= (cvtpk(ks1, ks1) << 16); v0p[r >> 1] |= (vw[r] << 16); v1p[r >> 1] |= (vw[r] & 0xffff0000u); }
                    else { k0p[r >> 1] = cvtpk(ks0, ks0) & 0xffffu; k1p[r >> 1] = cvtpk(ks1, ks1) & 0xffffu; v0p[r >> 1] = vw[r] & 0xffffu; v1p[r >> 1] = vw[r] >> 16; }
                }
                *(LAS v4u*)(L + SC_KST + (2 * lane) * SC_TS + 16 * w) = (v4u){k0p[0], k0p[1], k0p[2], k0p[3]}; *(LAS v4u*)(L + SC_KST + (2 * lane + 1) * SC_TS + 16 * w) = (v4u){k1p[0], k1p[1], k1p[2], k1p[3]};
                *(LAS v4u*)(L + SC_VT + (2 * lane) * SC_TS + 16 * w) = (v4u){v0p[0], v0p[1], v0p[2], v0p[3]}; *(LAS v4u*)(L + SC_VT + (2 * lane + 1) * SC_TS + 16 * w) = (v4u){v1p[0], v1p[1], v1p[2], v1p[3]};
                if (w == 0) *(LAS f32x2_t*)(L + SC_D + 8 * lane) = (f32x2_t){__expf(rr0[4]), __expf(rr1[4])};
            }
            const int p0c = ci < 4 ? 64 * ci : 64 * (ci - 4);
            const long orow0 = ci < 4 ? (long)NLAT + b * CTXL + (dir ? CTXL - 1 - p0c : p0c) : (long)b * SEQ + (dir ? SEQ - 1 - p0c : p0c);
            if (ci + 1 < ce) SC_LOAD(ci + 1);
            SC_LBAR();
            f32x4 O[4];
            if (!STATE_ONLY) {
#pragma unroll
                for (int rep = 0; rep < 2; ++rep) {
                    const int blk = w + 8 * rep;
                    if (blk < 10) {
                        const int cq = blk < 1 ? 0 : (blk < 3 ? 1 : (blk < 6 ? 2 : 3)), ck = blk - (cq * (cq + 1)) / 2;
                        const int ksoff = cq == 0 ? SC_KS0 : (cq == 1 ? SC_KS1 : (cq == 2 ? SC_KS2 : SC_KS3));
                        f32x4 acc = {0.f, 0.f, 0.f, 0.f};
#pragma unroll
                        for (int kk = 0; kk < 4; ++kk) {
                            const bf16x8_t a = *(const LAS bf16x8_t*)(L + ksoff + (16 * ck + li) * SC_RS + kk * 64 + q * 16);
                            const bf16x8_t bq = *(const LAS bf16x8_t*)(L + SC_QS + (16 * cq + li) * SC_RS + kk * 64 + q * 16);
                            acc = __builtin_amdgcn_mfma_f32_16x16x32_bf16(a, bq, acc, 0, 0, 0);
                        }
                        if (cq == ck) {
#pragma unroll
                            for (int r = 0; r < 4; ++r) if (4 * q + r > li) acc[r] = 0.f;
                        }
                        *(LAS v2u*)(L + SC_A + (16 * cq + li) * SC_TS + (16 * ck + 4 * q) * 2) = (v2u){cvtpk(acc[0], acc[1]), cvtpk(acc[2], acc[3])};
                    }
                }
#pragma unroll
                for (int it = 0; it < 4; ++it) O[it] = (f32x4){0.f, 0.f, 0.f, 0.f};
#pragma unroll
                for (int kk = 0; kk < 4; ++kk) {
                    const v4u sb = (v4u){cvtpk(S[2 * kk][0], S[2 * kk][1]), cvtpk(S[2 * kk][2], S[2 * kk][3]), cvtpk(S[2 * kk + 1][0], S[2 * kk + 1][1]), cvtpk(S[2 * kk + 1][2], S[2 * kk + 1][3])};
                    const bf16x8_t bs = __builtin_bit_cast(bf16x8_t, sb);
#pragma unroll
                    for (int it = 0; it < 4; ++it) {
                        const v2u a_lo = *(const LAS v2u*)(L + SC_QB + (16 * it + li) * SC_RS + kk * 64 + q * 8), a_hi = *(const LAS v2u*)(L + SC_QB + (16 * it + li) * SC_RS + kk * 64 + 32 + q * 8);
                        const bf16x8_t a = __builtin_bit_cast(bf16x8_t, (v4u){a_lo.x, a_lo.y, a_hi.x, a_hi.y});
                        O[it] = __builtin_amdgcn_mfma_f32_16x16x32_bf16(a, bs, O[it], 0, 0, 0);
                    }
                }
                SC_LBAR();
            }
            bf16x8_t bv[2];
#pragma unroll
            for (int is = 0; is < 2; ++is) bv[is] = *(const LAS bf16x8_t*)(L + SC_VT + (16 * w + li) * SC_TS + is * 64 + q * 16);
            if (!STATE_ONLY) {
#pragma unroll
                for (int it = 0; it < 4; ++it)
#pragma unroll
                    for (int ks = 0; ks < 2; ++ks) if (ks == 0 || it >= 2) {
                        const bf16x8_t a = *(const LAS bf16x8_t*)(L + SC_A + (16 * it + li) * SC_TS + ks * 64 + q * 16);
                        O[it] = __builtin_amdgcn_mfma_f32_16x16x32_bf16(a, bv[ks], O[it], 0, 0, 0);
                    }
                GAS float* Od = (GAS float*)(F.ws + (dir ? WS_OB : WS_OF));
#pragma unroll
                for (int it = 0; it < 4; ++it)
#pragma unroll
                    for (int r = 0; r < 4; ++r) { const int i = 16 * it + 4 * q + r; const long row = orow0 + (dir ? -i : i); Od[row * 1024 + h * 128 + 16 * w + li] = O[it][r]; }
            }
#pragma unroll
            for (int kt = 0; kt < 8; ++kt) {
                const f32x4 dv = *(const LAS f32x4*)(L + SC_D + (16 * kt + 4 * q) * 4);
                S[kt] = S[kt] * dv;
#pragma unroll
                for (int is = 0; is < 2; ++is) {
                    const bf16x8_t a = *(const LAS bf16x8_t*)(L + SC_KST + (16 * kt + li) * SC_TS + is * 64 + q * 16);
                    S[kt] = __builtin_amdgcn_mfma_f32_16x16x32_bf16(a, bv[is], S[kt], 0, 0, 0);
                }
            }
        }
#undef SC_LOAD
        if (STATE_ONLY) {
            GAS float* hp = HS + ((size_t)((seq * 8 + seg) * 8 + w) * 64 + lane) * 32;
#pragma unroll
            for (int kt = 0; kt < 8; ++kt) *(GAS f32x4*)(hp + 4 * kt) = S[kt];
            if (w == 0) *(GAS f32x2_t*)(DS + (size_t)(seq * 8 + seg) * 128 + 2 * lane) = (f32x2_t){__expf(segtot0), __expf(segtot1)};
        }
        SC_LBAR();
    }
}

__device__ __forceinline__ void readout_phase(Frame& F, int e, int nrows) {
    const GAS bf16* P = (const GAS bf16*)(F.ws + WS_P); GAS bf16* Y = (GAS bf16*)(F.ws + WS_Y);
    {
        const GAS float* OF = (const GAS float*)(F.ws + WS_OF); const GAS float* OB = (const GAS float*)(F.ws + WS_OB); const GAS float* ng = in_ptr(11) + (size_t)e * 1024;
        const int gw = F.bid * NWAVES + F.wave, NGW = F.G * NWAVES;
        for (int row = gw; row < nrows; row += NGW) {
            const int col = 16 * F.lane; f32x4 o[4]; float ss = 0.f;
#pragma unroll
            for (int j = 0; j < 4; ++j) { o[j] = *(const GAS f32x4*)(OF + (size_t)row * 1024 + col + 4 * j) + *(const GAS f32x4*)(OB + (size_t)row * 1024 + col + 4 * j);
                ss += (o[j][0] * o[j][0] + o[j][1] * o[j][1]) + (o[j][2] * o[j][2] + o[j][3] * o[j][3]); }
            ss += __shfl_xor(ss, 1); ss += __shfl_xor(ss, 2); ss += __shfl_xor(ss, 4);
            const float r = rsqrtf(ss * (1.0f / 128.0f) + EPS);
            const v4u s0 = *(const GAS v4u*)(P + (size_t)row * INC + 4096 + col), s1 = *(const GAS v4u*)(P + (size_t)row * INC + 4096 + col + 8);
            const float sgv[16] = {bflo(s0.x), bfhi(s0.x), bflo(s0.y), bfhi(s0.y), bflo(s0.z), bfhi(s0.z), bflo(s0.w), bfhi(s0.w), bflo(s1.x), bfhi(s1.x), bflo(s1.y), bfhi(s1.y), bflo(s1.z), bfhi(s1.z), bflo(s1.w), bfhi(s1.w)};
            float y[16];
#pragma unroll
            for (int j = 0; j < 4; ++j) { const f32x4 g4 = *(const GAS f32x4*)(ng + col + 4 * j);
#pragma unroll
                for (int q = 0; q < 4; ++q) y[4 * j + q] = o[j][q] * r * g4[q] * sgv[4 * j + q]; }
            v4u w0, w1; w0.x = pk2(y[0], y[1]); w0.y = pk2(y[2], y[3]); w0.z = pk2(y[4], y[5]); w0.w = pk2(y[6], y[7]); w1.x = pk2(y[8], y[9]); w1.y = pk2(y[10], y[11]); w1.z = pk2(y[12], y[13]); w1.w = pk2(y[14], y[15]);
            *(GAS v4u*)(Y + (size_t)row * D + col) = w0; *(GAS v4u*)(Y + (size_t)row * D + col + 8) = w1;
        }
    }
}
__device__ __forceinline__ void spatial_mfma_phase(Frame& F, int e, int nchunks) {
    const GAS bf16* P = (const GAS bf16*)(F.ws + WS_P); GAS bf16* Y = (GAS bf16*)(F.ws + WS_Y);
    LAS unsigned char* L = F.lds; constexpr int VP = 272;
    const GAS float* gv = in_ptr(14) + (size_t)e * 1024; const GAS float* bsp = in_ptr(13) + (size_t)e * 1024;
    const GAS bf16* wsb = (const GAS bf16*)(F.ws + WS_WSB) + (size_t)e * 8 * 128 * 128;
    const int w = F.wave, lane = F.lane, q = lane >> 4, li = lane & 15;
    const int nitems = nchunks * 8;
    if (F.bid >= nitems) return;
    const bool gfix = (F.G & 7) == 0; const int g0 = F.bid & 7;
    bf16x8_t wf[4];
#pragma unroll
    for (int ks = 0; ks < 4; ++ks) wf[ks] = *(const GAS bf16x8_t*)(wsb + ((size_t)g0 * 128 + 16 * w + li) * 128 + 32 * ks + 8 * q);
    unsigned xr[16];
#define SP_LOAD(item_) do { const int n_ = (item_) >> 3, g_ = (item_) & 7; const size_t rb_ = n_ < 128 ? (size_t)n_ * 128 : (size_t)NLAT + (size_t)(n_ - 128) * 128; \
        _Pragma("unroll") for (int i = 0; i < 16; ++i) xr[i] = *(const GAS unsigned*)(P + (rb_ + 16 * w + i) * INC + 6144 + g_ * 128 + 2 * lane); } while (0)
    SP_LOAD(F.bid);
    for (int item = F.bid; item < nitems; item += F.G) {
        const int n = item >> 3, g = item & 7; const size_t rowbase = n < 128 ? (size_t)n * 128 : (size_t)NLAT + (size_t)(n - 128) * 128;
        const float gva = gv[g * 128 + 2 * lane], gvb = gv[g * 128 + 2 * lane + 1];
        float s1[16], s2[16], x0[16], x1[16];
#pragma unroll
        for (int i = 0; i < 16; ++i) { x0[i] = bflo(xr[i]); x1[i] = bfhi(xr[i]); s1[i] = x0[i] + x1[i]; s2[i] = x0[i] * x0[i] + x1[i] * x1[i]; }
#pragma unroll
        for (int o = 1; o < 64; o <<= 1)
#pragma unroll
            for (int i = 0; i < 16; ++i) { s1[i] += __shfl_xor(s1[i], o); s2[i] += __shfl_xor(s2[i], o); }
#pragma unroll
        for (int i = 0; i < 16; i += 2) {
            const int s = 16 * w + i;
            const float ma = s1[i] * (1.0f / 128.0f), mb = s1[i + 1] * (1.0f / 128.0f);
            const float ra = rsqrtf(fmaxf(s2[i] * (1.0f / 128.0f) - ma * ma, 0.f) + EPS), rb = rsqrtf(fmaxf(s2[i + 1] * (1.0f / 128.0f) - mb * mb, 0.f) + EPS);
            *(LAS unsigned*)(L + (2 * lane) * VP + 2 * s) = cvtpk((x0[i] - ma) * ra * gva, (x0[i + 1] - mb) * rb * gva);
            *(LAS unsigned*)(L + (2 * lane + 1) * VP + 2 * s) = cvtpk((x1[i] - ma) * ra * gvb, (x1[i + 1] - mb) * rb * gvb);
        }
        if (item + F.G < nitems) SP_LOAD(item + F.G);
        __syncthreads();
        f32x4 acc[8];
#pragma unroll
        for (int ct = 0; ct < 8; ++ct) acc[ct] = (f32x4){0.f, 0.f, 0.f, 0.f};
#pragma unroll
        for (int ks = 0; ks < 4; ++ks) {
            const bf16x8_t wfk = gfix ? wf[ks] : *(const GAS bf16x8_t*)(wsb + ((size_t)g * 128 + 16 * w + li) * 128 + 32 * ks + 8 * q);
#pragma unroll
            for (int ct = 0; ct < 8; ++ct) {
                const bf16x8_t vf = *(const LAS bf16x8_t*)(L + (16 * ct + li) * VP + 64 * ks + 16 * q);
                acc[ct] = __builtin_amdgcn_mfma_f32_16x16x32_bf16(vf, wfk, acc[ct], 0, 0, 0);
            }
        }
        const int t = 16 * w + li; const float bias = bsp[g * 128 + t]; const size_t row = rowbase + t;
        v2u uw[8];
#pragma unroll
        for (int ct = 0; ct < 8; ++ct) uw[ct] = *(const GAS v2u*)(P + row * INC + 5120 + g * 128 + 16 * ct + 4 * q);
#pragma unroll
        for (int ct = 0; ct < 8; ++ct) {
            const int c = 16 * ct + 4 * q;
            *(GAS v2u*)(Y + row * D + 1024 + g * 128 + c) = (v2u){cvtpk(bflo(uw[ct].x) * (acc[ct][0] + bias), bfhi(uw[ct].x) * (acc[ct][1] + bias)), cvtpk(bflo(uw[ct].y) * (acc[ct][2] + bias), bfhi(uw[ct].y) * (acc[ct][3] + bias))};
        }
        __syncthreads();
    }
#undef SP_LOAD
}

__device__ __forceinline__ void pool_fast_phase(Frame& F, bool with_ctx) {
    const GAS bf16* PP = (const GAS bf16*)(F.ws + WS_P); GAS bf16* Y = (GAS bf16*)(F.ws + WS_Y);
    LAS float* vs = (LAS float*)F.lds;
    for (int br0 = F.bid; br0 < 256; br0 += F.G) {
        const int br = (F.G == 256) ? ((br0 & 7) * 32 + (br0 >> 3)) : br0;
        const int b = br >> 7, r = br & 127;
#pragma unroll 1
        for (int cblk = 0; cblk < 8; ++cblk) {
            const int g = cblk >> 1, k = 2 << g, half = k >> 1;
            const int rlo = max(r - half, 0), rhi = min(r - half + k, 128);
            unsigned lofs[4]; float s[4][8];
#pragma unroll
            for (int j = 0; j < 4; ++j) { const int idx = F.tid + 512 * j; lofs[j] = (unsigned)((b * SEQ + (idx >> 5)) * D + cblk * 256 + (idx & 31) * 8);
#pragma unroll
                for (int u = 0; u < 8; ++u) s[j][u] = 0.f; }
#pragma unroll 4
            for (int rr = rlo; rr < rhi; ++rr) {
                const unsigned ro = (unsigned)rr * (unsigned)(64 * D);
#pragma unroll
                for (int j = 0; j < 4; ++j) { const v4u x = *(const GAS v4u*)(PP + (lofs[j] + ro));
                    s[j][0] += bflo(x.x); s[j][1] += bfhi(x.x); s[j][2] += bflo(x.y); s[j][3] += bfhi(x.y); s[j][4] += bflo(x.z); s[j][5] += bfhi(x.z); s[j][6] += bflo(x.w); s[j][7] += bfhi(x.w); }
            }
#pragma unroll
            for (int j = 0; j < 4; ++j) { const int idx = F.tid + 512 * j, c = idx >> 5, vec = idx & 31;
                *(LAS f32x4*)(vs + c * 256 + vec * 8) = (f32x4){s[j][0], s[j][1], s[j][2], s[j][3]}; *(LAS f32x4*)(vs + c * 256 + vec * 8 + 4) = (f32x4){s[j][4], s[j][5], s[j][6], s[j][7]}; }
            __syncthreads();
            v4u sf[4];
#pragma unroll
            for (int j = 0; j < 4; ++j) sf[j] = *(const GAS v4u*)(PP + (lofs[j] + (unsigned)r * (unsigned)(64 * D)));
#pragma unroll
            for (int j = 0; j < 4; ++j) {
                const int idx = F.tid + 512 * j, c = idx >> 5, vec = idx & 31;
                const int clo = max(c - half, 0), chi = min(c - half + k, 64);
                f32x4 s0 = {0.f, 0.f, 0.f, 0.f}, s1 = s0;
#pragma unroll 4
                for (int cc = clo; cc < chi; ++cc) { s0 += *(const LAS f32x4*)(vs + cc * 256 + vec * 8); s1 += *(const LAS f32x4*)(vs + cc * 256 + vec * 8 + 4); }
                const float inv = 1.0f / (float)((rhi - rlo) * (chi - clo));
                v4u o; o.x = pk2(s0[0] * inv - bflo(sf[j].x), s0[1] * inv - bfhi(sf[j].x)); o.y = pk2(s0[2] * inv - bflo(sf[j].y), s0[3] * inv - bfhi(sf[j].y));
                o.z = pk2(s1[0] * inv - bflo(sf[j].z), s1[1] * inv - bfhi(sf[j].z)); o.w = pk2(s1[2] * inv - bflo(sf[j].w), s1[3] * inv - bfhi(sf[j].w));
                *(GAS v4u*)(Y + (lofs[j] + (unsigned)r * (unsigned)(64 * D))) = o;
            }
            __syncthreads();
        }
    }
    if (with_ctx) {
        const size_t total = (size_t)NCTX * 256, nthr = (size_t)F.G * NWAVES * 64;
        for (size_t idx = (size_t)F.bid * NWAVES * 64 + F.tid; idx < total; idx += nthr) {
            const int rowc = (int)(idx >> 8), col = (int)(idx & 255) * 8, g = col >> 9, k = 2 << g, half = k >> 1;
            const int b = rowc >> 8, t = rowc & 255, lo = max(t - half, 0), hi = min(t - half + k, CTXL);
            float sum[8];
#pragma unroll
            for (int j = 0; j < 8; ++j) sum[j] = 0.f;
            for (int tt = lo; tt < hi; ++tt) {
                const v4u w = *(const GAS v4u*)(PP + ((size_t)NLAT + b * CTXL + tt) * D + col);
                sum[0] += bflo(w.x); sum[1] += bfhi(w.x); sum[2] += bflo(w.y); sum[3] += bfhi(w.y); sum[4] += bflo(w.z); sum[5] += bfhi(w.z); sum[6] += bflo(w.w); sum[7] += bfhi(w.w);
            }
            const float inv = 1.0f / (float)(hi - lo);
            const size_t off = ((size_t)NLAT + rowc) * D + col;
            const v4u s = *(const GAS v4u*)(PP + off);
            v4u o; o.x = pk2(sum[0] * inv - bflo(s.x), sum[1] * inv - bfhi(s.x)); o.y = pk2(sum[2] * inv - bflo(s.y), sum[3] * inv - bfhi(s.y));
            o.z = pk2(sum[4] * inv - bflo(s.z), sum[5] * inv - bfhi(s.z)); o.w = pk2(sum[6] * inv - bflo(s.w), sum[7] * inv - bfhi(s.w));
            *(GAS v4u*)(Y + off) = o;
        }
    }
}

constexpr unsigned CODE_WARM_BYTES = 200 * 1024;
constexpr int N_PHASES = 31;
__global__ void __launch_bounds__(NWAVES * 64, 2) fwd(Args args) {
    extern __shared__ __attribute__((aligned(16))) unsigned char lds[];
    Frame F;
    F.lds = (LAS unsigned char*)lds;
    F.tid = threadIdx.x; F.lane = F.tid & 63; F.wave = __builtin_amdgcn_readfirstlane(F.tid >> 6);
    F.G = gridDim.x; F.bid = blockIdx.x;
    F.out = (GAS float*)args.out; F.ws = (GAS unsigned char*)args.ws;
    {
        unsigned long long pc_; asm volatile("s_getpc_b64 %0" : "=s"(pc_));
        const unsigned off_ = (unsigned)(((F.bid >> 3) * NWAVES + F.wave) * 1024 + F.lane * 16);
        if (off_ < CODE_WARM_BYTES) { const v4u c_ = *(const GAS v4u*)((pc_ & ~255ull) + off_); asm volatile("" :: "v"(c_)); }
    }
    for (int u = F.tid; u < (LDS_BYTES - LDSCTL_OFF) / 4; u += NWAVES * 64) ((LAS unsigned*)(F.lds + LDSCTL_OFF))[u] = 0u;
    __syncthreads();
    volatile LAS unsigned* MISC = (volatile LAS unsigned*)(F.lds + MISC_OFF);
    XcdBarrier bar; bar.bar = (unsigned*)(args.ws + WS_CTL) + CW_BAR; bar.x = 0; bar.st = nullptr;
    if (!MK_PER_PHASE) bar = xcd_barrier_post((unsigned*)(args.ws + WS_CTL) + CW_BAR, MISC + 8);
    const int lo = args.ph_lo, hi = args.ph_hi;
#ifndef SITE_MASK
#define SITE_MASK 0xFFFF
#endif
#define SITE(i) ((SITE_MASK >> (i)) & 1)
#define IN(k) (lo <= (k) && (k) < hi)
#define SEAM(k, kn) do { if (!MK_PER_PHASE && IN(k) && IN(kn)) xcd_barrier(bar); } while (0)
#define WSP(T, off) ((GAS T*)(F.ws + (off)))
#define MODS_L(L) ((const GAS float*)(F.ws + WS_MODS) + (size_t)(L) * 3 * NMOD)

    if (SITE(0) && IN(0)) { FRESH(F); prologue_phase(F); }
    SEAM(0, 1);
    if (SITE(1) && IN(1)) { FRESH(F); prep_phase(F); }
    SEAM(1, 2);
#define RS_(i) (WSP(unsigned long long, WS_RS) + (size_t)(i) * MR)
#define GS_(L, j) (WSP(const float, WS_GS) + (size_t)((L) * 2 + (j)) * 3 * D)
#define CB_(L, j) (WSP(const float, WS_CB) + (size_t)(L) * 3 * 16384 + ((j) ? 8192 : 0))
    for (int L = 0; L < 4; ++L) {
        const int pb = 2 + 7 * L, e = L >> 1;
        const bool cfull = L < 2;
        if ((L & 1) == 0) {
            if (SITE(2) && IN(pb + 0)) {
                FRESH(F);
                pg8::Gemm g{WSP(bf16, WS_H), WSP(const bf16, WS_WIN) + (size_t)e * INC * D, D, D, D, 0}; pg8::StaticOrder S; S.init((cfull ? MR : NLAT) / 256, INC / 256, F.G, F.bid, WGM_IN);
                pg8::EpiIn E{WSP(bf16, WS_P), WSP(float, WS_G), WSP(const float, WS_LB) + (size_t)e * 2048, WSP(bf16, WS_QH), WSP(bf16, WS_KH), WSP(bf16, WS_VH), RS_(2 * L), CB_(L, 0)};
                pg8::gemm_phase<pg8::EpiIn, true>(F.lds, g, S, E);
                if (L == 0) {
                    const int nunits = (MR / 256) * (INC / 256), nfull = nunits / F.G, nbusy = nunits - nfull * F.G;
                    if (F.bid >= nbusy) { FRESH(F); const int gw2 = __builtin_amdgcn_readfirstlane((F.bid - nbusy) * NWAVES + F.wave); cb_tables(F, 1, 4, gw2, (F.G - nbusy) * NWAVES); }
                }
                FRESH(F);
                cg::CEpiIn CE{WSP(bf16, WS_P), WSP(float, WS_G), WSP(const float, WS_LB) + (size_t)e * 2048, WSP(bf16, WS_QH), WSP(bf16, WS_KH), WSP(bf16, WS_VH), RS_(2 * L), CB_(L, 0) + 2 * 16384};
                if (!cfull) cg::ctx_gemm<cg::CEpiIn>(F.lds, F.bid, F.G, WSP(const bf16, WS_H) + (size_t)NLAT * D, D, WSP(const bf16, WS_WIN) + (size_t)e * INC * D, D, 1024, 4096, D, 0, NLAT, CE);
            }
            SEAM(pb + 0, pb + 1);
            if (SITE(3) && IN(pb + 1)) {
                if ((F.bid >> 3) & 1) { FRESH(F); spatial_mfma_phase(F, e, cfull ? 132 : 128); FRESH(F); scan_fast_phase<true>(F); }
                else { FRESH(F); scan_fast_phase<true>(F); FRESH(F); spatial_mfma_phase(F, e, cfull ? 132 : 128); }
            }
            SEAM(pb + 1, pb + 2);
            if (SITE(13) && IN(pb + 2)) { FRESH(F); scan_fast_phase<false>(F); }
            SEAM(pb + 2, pb + 3);
            if (SITE(4) && IN(pb + 3)) { FRESH(F); readout_phase(F, e, cfull ? MR : NLAT); }
            SEAM(pb + 3, pb + 4);
            if (SITE(5) && IN(pb + 4)) {
                FRESH(F);
                pg8::Gemm g{WSP(bf16, WS_Y), WSP(const bf16, WS_WOUT) + (size_t)e * D * D, D, D, D, 0}; pg8::StaticOrder S; S.init(NLAT / 256, D / 256, F.G, F.bid, WGM_OUT);
                pg8::EpiRes E{WSP(bf16, WS_X), in_ptr(0), L == 0, MODS_L(L) + 4096, NMOD, nullptr, nullptr, WSP(bf16, WS_H), GS_(L, 1), RS_(2 * L + 1), nullptr};
                pg8::gemm_phase<pg8::EpiRes, true>(F.lds, g, S, E);
                if (cfull) {
                    FRESH(F);
                    cg::CEpiRes CE{WSP(bf16, WS_X), in_ptr(2) - (size_t)NLAT * D, L == 0, MODS_L(L) + 2 * NMOD + 4096, nullptr, nullptr, WSP(bf16, WS_H), GS_(L, 1) + 2 * D, RS_(2 * L + 1)};
                    cg::ctx_gemm<cg::CEpiRes>(F.lds, F.bid, F.G, WSP(const bf16, WS_Y) + (size_t)NLAT * D, D, WSP(const bf16, WS_WOUT) + (size_t)e * D * D, D, 0, D, D, 0, NLAT, CE);
                }
            }
        } else {
            if (SITE(6) && IN(pb + 0)) {
                FRESH(F);
                pg8::Gemm g{WSP(bf16, WS_H), WSP(const bf16, WS_WP) + (size_t)e * D * D, D, D, D, 0}; pg8::StaticOrder S; S.init(NLAT / 256, D / 256, F.G, F.bid, WGM_PIN);
                pg8::EpiAct<0> E{WSP(bf16, WS_P), D, RS_(2 * L), CB_(L, 0)};
                pg8::gemm_phase<pg8::EpiAct<0>, true>(F.lds, g, S, E);
                if (cfull) {
                    FRESH(F);
                    cg::CEpiAct<0> CE{WSP(bf16, WS_P), D, RS_(2 * L), CB_(L, 0) + 2 * 16384};
                    cg::ctx_gemm<cg::CEpiAct<0>>(F.lds, F.bid, F.G, WSP(const bf16, WS_H) + (size_t)NLAT * D, D, WSP(const bf16, WS_WP) + (size_t)e * D * D, D, 0, D, D, 0, NLAT, CE);
                }
            }
            SEAM(pb + 0, pb + 1);
            if (SITE(7) && IN(pb + 1)) { FRESH(F); pool_fast_phase(F, cfull); }
            SEAM(pb + 1, pb + 4);
            if (SITE(8) && IN(pb + 4)) {
                FRESH(F);
                pg8::Gemm g{WSP(bf16, WS_Y), WSP(const bf16, WS_WG) + (size_t)e * D * 512, D, 512, 512, 512}; pg8::StaticOrder S; S.init(NLAT / 256, D / 256, F.G, F.bid, WGM_GRP);
                pg8::EpiRes E{WSP(bf16, WS_X), nullptr, false, MODS_L(L) + 4096, NMOD, in_ptr(17) + (size_t)e * D, in_ptr(18) + (size_t)e * D, WSP(bf16, WS_H), GS_(L, 1), RS_(2 * L + 1), nullptr};
                pg8::gemm_phase<pg8::EpiRes, true>(F.lds, g, S, E);
                if (cfull) {
                    FRESH(F);
                    cg::CEpiRes CE{WSP(bf16, WS_X), nullptr, false, MODS_L(L) + 2 * NMOD + 4096, in_ptr(17) + (size_t)e * D, in_ptr(18) + (size_t)e * D, WSP(bf16, WS_H), GS_(L, 1) + 2 * D, RS_(2 * L + 1)};
                    cg::ctx_gemm<cg::CEpiRes>(F.lds, F.bid, F.G, WSP(const bf16, WS_Y) + (size_t)NLAT * D, D, WSP(const bf16, WS_WG) + (size_t)e * D * 512, 512, 0, D, 512, 512, NLAT, CE);
                }
            }
        }
        SEAM(pb + 4, pb + 5);
        if (SITE(10) && IN(pb + 5)) {
            FRESH(F);
            pg8::Gemm g{WSP(bf16, WS_H), WSP(const bf16, WS_WUP) + (size_t)L * DFF * D, D, D, D, 0}; pg8::StaticOrder S; S.init((cfull ? MR : NLAT) / 256, DFF / 256, F.G, F.bid, WGM_UP);
            pg8::EpiAct<1> E{WSP(bf16, WS_HID), DFF, RS_(2 * L + 1), CB_(L, 1)};
            pg8::gemm_phase<pg8::EpiAct<1>, true>(F.lds, g, S, E);
        }
        SEAM(pb + 5, pb + 6);
        if (SITE(11) && IN(pb + 6)) {
            FRESH(F);
            pg8::Gemm g{WSP(bf16, WS_HID), WSP(const bf16, WS_WDN) + (size_t)L * D * DFF, DFF, DFF, DFF, 0}; pg8::StaticOrder S; S.init(NLAT / 256, D / 256, F.G, F.bid, WGM_DN);
            pg8::EpiRes E{WSP(bf16, WS_X), nullptr, false, MODS_L(L) + 10240, NMOD, nullptr, nullptr, L < 3 ? WSP(bf16, WS_H) : (GAS bf16*)nullptr, GS_(L + 1, 0), RS_(2 * L + 2), L == 3 ? F.out : (GAS float*)nullptr};
            pg8::gemm_phase<pg8::EpiRes, true>(F.lds, g, S, E);
            if (cfull) {
                FRESH(F);
                cg::CEpiRes CE{WSP(bf16, WS_X), nullptr, false, MODS_L(L) + 2 * NMOD + 10240, nullptr, nullptr, WSP(bf16, WS_H), GS_(L + 1, 0) + 2 * D, RS_(2 * L + 2)};
                cg::ctx_gemm<cg::CEpiRes>(F.lds, F.bid, F.G, WSP(const bf16, WS_HID) + (size_t)NLAT * DFF, DFF, WSP(const bf16, WS_WDN) + (size_t)L * D * DFF, DFF, 0, D, DFF, 0, NLAT, CE);
            }
        }
        SEAM(pb + 6, pb + 7);
    }
    if (SITE(12) && IN(30)) { FRESH(F); final_norm_phase(F); }
#undef IN
#undef SEAM
}

extern "C" void kernel_launch(void* const* d_in, const int* in_sizes, int n_in, void* d_out, int out_size, void* d_ws, size_t ws_size, hipStream_t stream) {
    static int grid = 0;
    if (grid == 0) {
        if (n_in != 22 || in_sizes[0] != NLAT * D || out_size != NLAT * D || ws_size < WS_END) {
            fprintf(stderr, "kernel_launch: unexpected shapes (n_in %d, in0 %d, out %d, ws %zu, need %zu); nothing launched\n", n_in, n_in > 0 ? in_sizes[0] : -1, out_size, ws_size, (size_t)WS_END); grid = -1; return; }
        int dev = 0, cus = 0, per_cu = 0;
        if (hipGetDevice(&dev) != hipSuccess || hipDeviceGetAttribute(&cus, hipDeviceAttributeMultiprocessorCount, dev) != hipSuccess) { fprintf(stderr, "kernel_launch: device query failed\n"); grid = -1; return; }
        if (hipFuncSetAttribute((const void*)fwd, hipFuncAttributeMaxDynamicSharedMemorySize, LDS_BYTES) != hipSuccess) { fprintf(stderr, "kernel_launch: hipFuncSetAttribute failed\n"); grid = -1; return; }
        if (hipOccupancyMaxActiveBlocksPerMultiprocessor(&per_cu, (const void*)fwd, NWAVES * 64, LDS_BYTES) != hipSuccess || per_cu < 1)
            fprintf(stderr, "kernel_launch: note: occupancy query reports %d workgroups per CU\n", per_cu);
        (void)hipGetLastError();
        grid = cus;
    }
    if (grid < 0) return;
    if (hipMemsetAsync((char*)d_ws + WS_CTL, 0, CTL_ZERO_BYTES, stream) != hipSuccess) { fprintf(stderr, "kernel_launch: memset failed\n"); return; }
    Args a{};
    for (int i = 0; i < 22; ++i) a.in[i] = (const float*)d_in[i];
    a.out = (float*)d_out; a.ws = (unsigned char*)d_ws;
#if MK_PER_PHASE
    for (int ph = 0; ph < N_PHASES; ++ph) {
        if (ph >= 2 && ph <= 29) { const int L = (ph - 2) / 7, s = (ph - 2) % 7; if ((L & 1) && (s == 2 || s == 3)) continue; }
        a.ph_lo = ph; a.ph_hi = ph + 1;
        hipLaunchKernelGGL(fwd, dim3(grid), dim3(NWAVES * 64), LDS_BYTES, stream, a);
    }
#else
    a.ph_lo = 0; a.ph_hi = N_PHASES;
    hipLaunchKernelGGL(fwd, dim3(grid), dim3(NWAVES * 64), LDS_BYTES, stream, a);
#endif
    const hipError_t le = hipPeekAtLastError();
    if (le != hipSuccess) fprintf(stderr, "kernel_launch: launch failed: %s\n", hipGetErrorName(le));
}
```
